# Optimizing an MI355X kernel written in HIP

```python
import jax, jax.numpy as jnp
from jax import lax
import numpy as np

D_MODEL = 2048
BATCH = 1
SEQ = 16384
DEPTH = 2
DEC_BATCH = 16
DEC_SEQ = 2048
PAST_LEN = 128

GRID_W = 64
PLE_DIM = 256
EPS = 1e-6
Q_BLOCK = 128
ROPE_THETA = 10000.0

NA_HEADS = 8
NA_HEAD_DIM = 64
NA_WIN_H = 8
NA_WIN_W = 16
NA_WIDTH = NA_HEADS * NA_HEAD_DIM

MLA_HEADS = 6
MLA_NOPE = 128
MLA_ROPE = 64
MLA_V = 128
MLA_Q_LORA = 512
MLA_KV_LORA = 256
MLA_WIDTH = MLA_HEADS * MLA_V

GQA_HEADS = 12
GQA_KV_HEADS = 4
GQA_HEAD_DIM = 64
GQA_GROUP = GQA_HEADS // GQA_KV_HEADS
GQA_WIDTH = GQA_HEADS * GQA_HEAD_DIM
GQA_KV_WIDTH = GQA_KV_HEADS * GQA_HEAD_DIM

MIX_WIDTH = NA_WIDTH + MLA_WIDTH + GQA_WIDTH
IN_SPLITS = (NA_WIDTH, NA_WIDTH, NA_WIDTH, NA_WIDTH,
             MLA_Q_LORA, MLA_KV_LORA, MLA_ROPE, MLA_WIDTH,
             GQA_WIDTH, GQA_KV_WIDTH, GQA_KV_WIDTH, GQA_WIDTH)
IN_COLS = sum(IN_SPLITS)

kernel_name = "hybrid_na_mla_gqa_encoder"


def rms_norm(x, g):
    xf = x.astype(jnp.float32)
    y = xf * lax.rsqrt(jnp.mean(xf * xf, axis=-1, keepdims=True) + EPS)
    return (y * g.astype(jnp.float32)).astype(x.dtype)


def rope_tables(pos, dim, dtype):
    inv = ROPE_THETA ** (-jnp.arange(0, dim, 2, dtype=jnp.float32) / dim)
    ang = pos.astype(jnp.float32)[:, None] * inv[None, :]
    ang = jnp.concatenate([ang, ang], axis=-1)
    return jnp.cos(ang).astype(dtype), jnp.sin(ang).astype(dtype)


def apply_rope(x, cos, sin):
    half = x.shape[-1] // 2
    x1, x2 = x[..., :half], x[..., half:]
    rot = jnp.concatenate([-x2, x1], axis=-1)
    return x * cos + rot * sin


def neighborhood_attention(q, k, v, rpb):
    B, S, H, D = q.shape
    rows = S // GRID_W
    kh = min(NA_WIN_H, rows)
    kw = min(NA_WIN_W, GRID_W)
    r = jnp.arange(rows)
    c = jnp.arange(GRID_W)
    rs = jnp.clip(r - kh // 2, 0, rows - kh)
    cs = jnp.clip(c - kw // 2, 0, GRID_W - kw)
    key_r = rs[:, None] + jnp.arange(kh)
    key_c = cs[:, None] + jnp.arange(kw)
    idx = (key_r[:, None, :, None] * GRID_W + key_c[None, :, None, :]).reshape(rows, GRID_W, kh * kw)
    di = key_r - r[:, None] + (NA_WIN_H - 1)
    dj = key_c - c[:, None] + (NA_WIN_W - 1)
    qb = q.reshape(B, rows, GRID_W, H, D).transpose(1, 0, 2, 3, 4)
    scale = D ** -0.5

    def row_block(args):
        q_b, idx_b, di_b = args
        k_g = jnp.take(k, idx_b, axis=1)
        v_g = jnp.take(v, idx_b, axis=1)
        s = jnp.einsum('bqhd,bqkhd->bhqk', q_b, k_g).astype(jnp.float32) * scale
        bias = rpb[:, di_b[:, None, None], dj[None, :, :]]
        bias = bias.transpose(0, 2, 1, 3).reshape(H, GRID_W, kh * kw).astype(jnp.float32)
        p = jax.nn.softmax(s + bias[None], axis=-1).astype(v.dtype)
        return jnp.einsum('bhqk,bqkhd->bqhd', p, v_g)

    out = lax.map(row_block, (qb, idx, di))
    return out.transpose(1, 0, 2, 3, 4).reshape(B, S, H * D)


def mla_attention(q_nope, q_rope, k_nope, k_rope, v):
    B, S, H, _ = q_nope.shape
    nb = S // Q_BLOCK
    qn = q_nope.reshape(B, nb, Q_BLOCK, H, MLA_NOPE).transpose(1, 0, 2, 3, 4)
    qr = q_rope.reshape(B, nb, Q_BLOCK, H, MLA_ROPE).transpose(1, 0, 2, 3, 4)
    scale = (MLA_NOPE + MLA_ROPE) ** -0.5

    def q_block(args):
        qn_b, qr_b = args
        s = (jnp.einsum('bqhd,bkhd->bhqk', qn_b, k_nope)
             + jnp.einsum('bqhr,bkr->bhqk', qr_b, k_rope))
        p = jax.nn.softmax(s.astype(jnp.float32) * scale, axis=-1).astype(v.dtype)
        return jnp.einsum('bhqk,bkhd->bqhd', p, v)

    out = lax.map(q_block, (qn, qr))
    return out.transpose(1, 0, 2, 3, 4).reshape(B, S, H * MLA_V)


def gqa_attention(q, k, v):
    B, S, _, D = q.shape
    nb = S // Q_BLOCK
    qg = q.reshape(B, nb, Q_BLOCK, GQA_KV_HEADS, GQA_GROUP, D).transpose(1, 0, 2, 3, 4, 5)
    scale = D ** -0.5

    def q_block(q_b):
        s = jnp.einsum('bqhgd,bkhd->bhgqk', q_b, k).astype(jnp.float32) * scale
        p = jax.nn.softmax(s, axis=-1).astype(v.dtype)
        return jnp.einsum('bhgqk,bkhd->bqhgd', p, v)

    out = lax.map(q_block, qg)
    return out.transpose(1, 0, 2, 3, 4, 5).reshape(B, S, GQA_HEADS * D)


def encoder_layer(x, p_l, norm_g, w_in, na_rpb, q_a_norm, w_q_b, kv_a_norm, w_kv_b,
                  gqa_q_norm, gqa_k_norm, w_out, ple_norm, w_pe, w_pg, pos_tabs):
    B, S, _ = x.shape
    cos_t, sin_t, cos_r, sin_r, cos_c, sin_c = pos_tabs
    h = rms_norm(x, norm_g)
    proj = h @ w_in
    cuts = np.cumsum(IN_SPLITS)[:-1].tolist()
    (na_q, na_k, na_v, na_g, c_q, c_kv, k_rope, mla_g,
     g_q, g_k, g_v, gqa_g) = jnp.split(proj, cuts, axis=-1)

    shp = (B, S, NA_HEADS, NA_HEAD_DIM)
    y_na = neighborhood_attention(na_q.reshape(shp), na_k.reshape(shp), na_v.reshape(shp), na_rpb)
    y_na = y_na * jax.nn.silu(na_g)

    q = (rms_norm(c_q, q_a_norm) @ w_q_b).reshape(B, S, MLA_HEADS, MLA_NOPE + MLA_ROPE)
    q_nope, q_rope = q[..., :MLA_NOPE], q[..., MLA_NOPE:]
    q_rope = apply_rope(q_rope, cos_t[:, None, :], sin_t[:, None, :])
    kv = (rms_norm(c_kv, kv_a_norm) @ w_kv_b).reshape(B, S, MLA_HEADS, MLA_NOPE + MLA_V)
    k_nope, v_mla = kv[..., :MLA_NOPE], kv[..., MLA_NOPE:]
    k_rope = apply_rope(k_rope, cos_t, sin_t)
    y_mla = mla_attention(q_nope, q_rope, k_nope, k_rope, v_mla) * jax.nn.silu(mla_g)

    half = GQA_HEAD_DIM // 2
    def axial(t):
        return jnp.concatenate([
            apply_rope(t[..., :half], cos_r[:, None, :], sin_r[:, None, :]),
            apply_rope(t[..., half:], cos_c[:, None, :], sin_c[:, None, :])], axis=-1)
    qg = axial(rms_norm(g_q.reshape(B, S, GQA_HEADS, GQA_HEAD_DIM), gqa_q_norm))
    kg = axial(rms_norm(g_k.reshape(B, S, GQA_KV_HEADS, GQA_HEAD_DIM), gqa_k_norm))
    vg = g_v.reshape(B, S, GQA_KV_HEADS, GQA_HEAD_DIM)
    y_gqa = gqa_attention(qg, kg, vg) * jax.nn.silu(gqa_g)

    mixed = jnp.concatenate([y_na, y_mla, y_gqa], axis=-1) @ w_out
    x = x + mixed

    gate = jax.nn.sigmoid(rms_norm(x, ple_norm) @ w_pg)
    return x + (p_l @ w_pe) * gate


def run_trunk(x, p, norm_g, w_in, na_rpb, mla_q_a_norm, mla_w_q_b, mla_kv_a_norm, mla_w_kv_b,
              gqa_q_norm, gqa_k_norm, w_out, ple_norm, w_pe, w_pg, final_norm):
    S = x.shape[1]
    t = jnp.arange(S)
    row, col = t // GRID_W, t % GRID_W
    cos_t, sin_t = rope_tables(t, MLA_ROPE, x.dtype)
    cos_r, sin_r = rope_tables(row, GQA_HEAD_DIM // 2, x.dtype)
    cos_c, sin_c = rope_tables(col, GQA_HEAD_DIM // 2, x.dtype)
    pos_tabs = (cos_t, sin_t, cos_r, sin_r, cos_c, sin_c)
    for i in range(DEPTH):
        x = encoder_layer(x, p[i], norm_g[i], w_in[i], na_rpb[i], mla_q_a_norm[i], mla_w_q_b[i],
                          mla_kv_a_norm[i], mla_w_kv_b[i], gqa_q_norm[i], gqa_k_norm[i], w_out[i],
                          ple_norm[i], w_pe[i], w_pg[i], pos_tabs)
    return rms_norm(x, final_norm)


def setup_inputs(seed: int = 0) -> dict:
    key = jax.random.key(seed)
    ks = jax.random.split(key, 20)
    f32 = jnp.float32
    nrm = lambda k, shape, s: jax.random.normal(k, shape, f32) * s
    gain = lambda k, shape: 1.0 + 0.02 * jax.random.normal(k, shape, f32)
    return {
        "x_prompt": nrm(ks[0], (BATCH, SEQ, D_MODEL), 1.0),
        "x_sample": nrm(ks[1], (DEC_BATCH, DEC_SEQ, D_MODEL), 1.0),
        "p_prompt": nrm(ks[2], (DEPTH, BATCH, SEQ, PLE_DIM), 1.0),
        "p_sample": nrm(ks[3], (DEPTH, DEC_BATCH, DEC_SEQ, PLE_DIM), 1.0),
        "norm_g": gain(ks[4], (DEPTH, D_MODEL)),
        "w_in": nrm(ks[5], (DEPTH, D_MODEL, IN_COLS), D_MODEL ** -0.5),
        "na_rpb": nrm(ks[6], (DEPTH, NA_HEADS, 2 * NA_WIN_H - 1, 2 * NA_WIN_W - 1), 0.1),
        "mla_q_a_norm": gain(ks[7], (DEPTH, MLA_Q_LORA)),
        "mla_w_q_b": nrm(ks[8], (DEPTH, MLA_Q_LORA, MLA_HEADS * (MLA_NOPE + MLA_ROPE)), MLA_Q_LORA ** -0.5),
        "mla_kv_a_norm": gain(ks[9], (DEPTH, MLA_KV_LORA)),
        "mla_w_kv_b": nrm(ks[10], (DEPTH, MLA_KV_LORA, MLA_HEADS * (MLA_NOPE + MLA_V)), MLA_KV_LORA ** -0.5),
        "gqa_q_norm": gain(ks[11], (DEPTH, GQA_HEAD_DIM)),
        "gqa_k_norm": gain(ks[12], (DEPTH, GQA_HEAD_DIM)),
        "w_out": nrm(ks[13], (DEPTH, MIX_WIDTH, D_MODEL), MIX_WIDTH ** -0.5),
        "ple_norm": gain(ks[14], (DEPTH, D_MODEL)),
        "w_pe": nrm(ks[15], (DEPTH, PLE_DIM, D_MODEL), PLE_DIM ** -0.5),
        "w_pg": nrm(ks[16], (DEPTH, D_MODEL, D_MODEL), D_MODEL ** -0.5),
        "final_norm": gain(ks[17], (D_MODEL,)),
    }


def reference(x_prompt, x_sample, p_prompt, p_sample, norm_g, w_in, na_rpb, mla_q_a_norm, mla_w_q_b,
              mla_kv_a_norm, mla_w_kv_b, gqa_q_norm, gqa_k_norm, w_out, ple_norm, w_pe, w_pg, final_norm):
    y_prompt = run_trunk(x_prompt, p_prompt, norm_g, w_in, na_rpb, mla_q_a_norm, mla_w_q_b, mla_kv_a_norm,
                         mla_w_kv_b, gqa_q_norm, gqa_k_norm, w_out, ple_norm, w_pe, w_pg, final_norm)
    y_sample = run_trunk(x_sample, p_sample, norm_g, w_in, na_rpb, mla_q_a_norm, mla_w_q_b, mla_kv_a_norm,
                         mla_w_kv_b, gqa_q_norm, gqa_k_norm, w_out, ple_norm, w_pe, w_pg, final_norm)
    return (y_prompt, y_sample)
```

```cpp
#include <hip/hip_runtime.h>
#include <cstdio>
#include <cstdint>

#ifndef MK_PER_PHASE
#define MK_PER_PHASE 1
#endif

#define LAS __attribute__((address_space(3)))
#define GAS __attribute__((address_space(1)))
typedef unsigned short bf16_t;
typedef short bf16x8 __attribute__((ext_vector_type(8)));
typedef short s16x4 __attribute__((ext_vector_type(4)));
typedef float f32x2 __attribute__((ext_vector_type(2)));
typedef float f32x4 __attribute__((ext_vector_type(4)));
typedef float f32x16 __attribute__((ext_vector_type(16)));
typedef unsigned u32x2 __attribute__((ext_vector_type(2)));
typedef unsigned u32x4 __attribute__((ext_vector_type(4)));
typedef GAS unsigned gu32;

constexpr int DM = 2048, NTOK = 49152, SEQ_P = 16384, SEQ_S = 2048, PLE = 256;
constexpr int IN_COLS = 5696, LDP = 5888;
constexpr int GROWS0 = 32768, GROWS1 = 16384, GMAX = 32768;
constexpr float EPS = 1e-6f;
constexpr int C_NAQ = 0, C_MLAG = 512, C_GQ = 1280, C_NAK = 2048, C_NAV = 2560, C_NAG = 3072, C_CQ = 3584, C_CKV = 4096, C_GK = 4352, C_GV = 4608, C_GQG = 4864, C_KR = 5632;
constexpr int LDQ = 1280, LDKV = 1536;
constexpr int TILE_CQ0 = C_CQ / 256, TILE_CKV = C_CKV / 256;

constexpr size_t MiB = 1u << 20;
constexpr size_t WS_CTL = 0, CTL_ZERO_BYTES = 1 * MiB;
constexpr size_t SZ_W1 = (size_t)LDP * DM * 2, SZ_WQB = (size_t)LDQ * 512 * 2, SZ_WKVB = (size_t)LDKV * 256 * 2, SZ_WSQ = (size_t)DM * DM * 2, SZ_WPE = (size_t)DM * PLE * 2;
constexpr size_t WS_W1 = 1 * MiB;
constexpr size_t WS_WQB = WS_W1 + 2 * SZ_W1;
constexpr size_t WS_WKVB = WS_WQB + 2 * SZ_WQB;
constexpr size_t WS_WOUT = WS_WKVB + 2 * SZ_WKVB;
constexpr size_t WS_WPG = WS_WOUT + 2 * SZ_WSQ;
constexpr size_t WS_WPE = WS_WPG + 2 * SZ_WSQ;
constexpr size_t WS_ROPET = WS_WPE + 2 * SZ_WPE;
constexpr size_t WS_ROWT = WS_ROPET + (size_t)SEQ_P * 32 * 8;
constexpr size_t WS_COLT = WS_ROWT + 256 * 16 * 8;
constexpr size_t WS_S1 = ((WS_COLT + 64 * 16 * 8 + 4095) / 4096) * 4096;
constexpr size_t WS_S2 = WS_S1 + (size_t)GMAX * 32 * 4;
constexpr size_t WS_SQ = WS_S2 + (size_t)GMAX * 32 * 4;
constexpr size_t WS_SKV = WS_SQ + (size_t)GMAX * 8 * 4;
constexpr size_t WS_PB = WS_SKV + (size_t)GMAX * 4 * 4;
constexpr size_t WS_XB0 = WS_PB + (size_t)2 * GMAX * PLE * 2;
constexpr size_t WS_XB1 = WS_XB0 + (size_t)GMAX * DM * 2;
constexpr size_t WS_PROJ = WS_XB1 + (size_t)GMAX * DM * 2;
constexpr size_t WS_Q = WS_PROJ + (size_t)GMAX * LDP * 2;
constexpr size_t WS_KV = WS_Q + (size_t)GMAX * LDQ * 2;
constexpr size_t WS_PE = WS_Q;
constexpr size_t WS_END = WS_KV + (size_t)GMAX * LDKV * 2;
static_assert(WS_PE + (size_t)GMAX * DM * 2 <= WS_END, "PE overlay fits Q|KV");
static_assert(WS_END <= (size_t)1024 * MiB, "workspace map fits 1 GiB");
constexpr int CW_BAR = 4096;
constexpr int CW_QUEUE = 16384;

constexpr int RING_BYTES = 131072;
constexpr int TBL_OFF = RING_BYTES;
constexpr int MISC_OFF = TBL_OFF + 2048;
constexpr int LDS_BYTES = MISC_OFF + 256;
constexpr int A_KOFF = 0, A_KMAX = 24 * 1040;
constexpr int A_VOFF = 2 * 25088, A_VMAX = 16384;
constexpr int A_WSOFF = A_VOFF + 2 * A_VMAX;
constexpr int A_BOFF = A_WSOFF + 2048;
static_assert(A_KMAX <= 25088 && A_BOFF + 2048 <= RING_BYTES, "attention LDS map");

__device__ __forceinline__ unsigned cvt_pk_bf16(float lo, float hi) { unsigned r; asm volatile("v_cvt_pk_bf16_f32 %0, %1, %2" : "=v"(r) : "v"(lo), "v"(hi)); return r; }
__device__ __forceinline__ float bf_lo(unsigned w) { return __uint_as_float(w << 16); }
__device__ __forceinline__ float bf_hi(unsigned w) { return __uint_as_float(w & 0xffff0000u); }
__device__ __forceinline__ float bf2f(short s) { return __uint_as_float(((unsigned)(unsigned short)s) << 16); }
#define LDS_WAIT() asm volatile("s_waitcnt lgkmcnt(0)" ::: "memory")
#define VM_WAIT() asm volatile("s_waitcnt vmcnt(0)" ::: "memory")
#define SBAR() __builtin_amdgcn_sched_barrier(0)
__device__ __forceinline__ int opaque_tid() { int t = threadIdx.x; asm volatile("" : "+v"(t)); return t; }
__device__ __forceinline__ float wave_sum(float v) {
#pragma unroll
    for (int o = 1; o < 64; o <<= 1) v += __shfl_xor(v, o);
    return v;
}

namespace pg8 {
constexpr int BM = 256, BK = 64, HALF = 128, HTB = HALF * BK * 2, NXCD = 8, WGM = 8;
__host__ __device__ __forceinline__ int lds_byte(int r, int c) { const int st = (r >> 4) * 2 + (c >> 5), rr = r & 15, cc = c & 31, ob = rr * 64 + cc * 2; return st * 1024 + (ob ^ (((ob >> 9) & 1) << 5)); }
__host__ __device__ __forceinline__ void stage_rc(int b, int& R, int& C) { const int st = b / 1024, sb = b % 1024, swz = sb ^ (((sb >> 9) & 1) << 5); R = (st >> 1) * 16 + swz / 64; C = (st & 1) * 32 + (swz % 64) / 2; }
__host__ __device__ __forceinline__ int perm32(int rho) { const int n = rho >> 4, i = rho & 15; return 8 * (i >> 2) + 4 * n + (i & 3); }

struct Unit { int pm, pn; };
struct Gemm { const bf16_t* A; const bf16_t* Bt; };

struct StaticOrder {
    int nM, nN, nwg, G, c;
    __device__ __forceinline__ void init(int nM_, int nN_, int G_, int c_) { nM = nM_; nN = nN_; nwg = nM * nN; G = G_; c = c_; }
    __device__ __forceinline__ bool next(int i, Unit& u) const {
        const long L = (long)i * G + c; if (L >= nwg) return false;
        int wgid = (int)L; { const int q = nwg / NXCD, r = nwg % NXCD, xcd = wgid % NXCD, off = wgid / NXCD; wgid = (xcd < r ? xcd * (q + 1) : r * (q + 1) + (xcd - r) * q) + off; }
        const int nig = WGM * nN, gid = wgid / nig, fm = gid * WGM, gsz = (nM - fm) < WGM ? (nM - fm) : WGM;
        u.pm = fm + ((wgid % nig) % gsz); u.pn = (wgid % nig) / gsz; return true;
    }
};

template <int LDA, int K, class Epi>
__device__ __forceinline__ void gemm_phase(LAS unsigned char* lds, const Gemm g, const StaticOrder& S, const Epi& E) {
    const int tid = opaque_tid(), wid = __builtin_amdgcn_readfirstlane(tid >> 6), lane = tid & 63, wr = wid >> 2, wc = wid & 3, fr = lane & 15, fq = lane >> 4;
    constexpr int nt = K / BK;
    unsigned voffA[2], voffB[2];
#pragma unroll
    for (int i = 0; i < 2; ++i) { int R, C; stage_rc(tid * 16 + i * 8192, R, C); const int Rb = (R & ~31) + perm32(R & 31);
        voffA[i] = (unsigned)(R * LDA + C) * 2u; voffB[i] = (unsigned)(Rb * K + C) * 2u; }
    constexpr size_t kstep = (size_t)(BK * 2);
    constexpr size_t hstepA = (size_t)HALF * LDA * 2, hstepB = (size_t)HALF * K * 2;
    constexpr size_t tstepA = 2 * hstepA, tstepB = 2 * hstepB;
    const unsigned ldsw = (unsigned)wid * 1024u;
    const int aoff = lds_byte(wr * 64 + fr, fq * 8), boff = lds_byte(wc * 32 + fr, fq * 8);
#define PG8_SA(b, h) (((b) * 2 + (h)) * HTB)
#define PG8_SB(b, h) ((4 + (b) * 2 + (h)) * HTB)
#define PG8_STAGE(bufoff, gbase, voff) do { _Pragma("unroll") for (int _i = 0; _i < 2; ++_i) \
        __builtin_amdgcn_global_load_lds((const unsigned*)((const char*)(gbase) + (voff)[_i]), (LAS unsigned*)(lds + (bufoff) + ldsw + _i * 8192), 16, 0, 0); } while (0)
#define PG8_LDA(dst, b, h) do { _Pragma("unroll") for (int m = 0; m < 4; ++m) _Pragma("unroll") for (int k = 0; k < 2; ++k) dst[m][k] = *(const LAS bf16x8*)(lds + PG8_SA(b, h) + aoff + m * 2048 + k * 1024); } while (0)
#define PG8_LDB(dst, b, h) do { _Pragma("unroll") for (int n = 0; n < 2; ++n) _Pragma("unroll") for (int k = 0; k < 2; ++k) dst[n][k] = *(const LAS bf16x8*)(lds + PG8_SB(b, h) + boff + n * 2048 + k * 1024); } while (0)
#define PG8_MMA(ai, bj, At, Bt) do { __builtin_amdgcn_s_setprio(1); _Pragma("unroll") for (int m = 0; m < 4; ++m) _Pragma("unroll") for (int n = 0; n < 2; ++n) _Pragma("unroll") for (int k = 0; k < 2; ++k) \
        acc[ai][bj][m][n] = __builtin_amdgcn_mfma_f32_16x16x32_bf16(Bt[n][k], At[m][k], acc[ai][bj][m][n], 0, 0, 0); __builtin_amdgcn_s_setprio(0); } while (0)
#define PG8_WAIT_V(n) asm volatile("s_waitcnt vmcnt(" #n ")" ::: "memory")
#define PG8_WAIT_L(n) asm volatile("s_waitcnt lgkmcnt(" #n ")" ::: "memory")
#define PG8_BAR __builtin_amdgcn_s_barrier()
#define PG8_SCHED __builtin_amdgcn_sched_barrier(0)
    Unit cur, nxt; int ui = 0;
    if (!S.next(0, cur)) return;
    f32x4 acc[2][2][4][2];
#pragma unroll
    for (int a = 0; a < 2; ++a)
#pragma unroll
        for (int b = 0; b < 2; ++b)
#pragma unroll
            for (int m = 0; m < 4; ++m)
#pragma unroll
                for (int n = 0; n < 2; ++n) acc[a][b][m][n] = (f32x4){0.f, 0.f, 0.f, 0.f};
    bf16x8 At[4][2], B0[2][2], B1[2][2];
    const char* cA = (const char*)g.A + (size_t)cur.pm * tstepA; const char* cB = (const char*)g.Bt + (size_t)cur.pn * tstepB;
    E.prep(cur, 0, lds, tid);
    PG8_STAGE(PG8_SB(0, 0), cB, voffB); PG8_STAGE(PG8_SB(0, 1), cB + hstepB, voffB); PG8_STAGE(PG8_SA(0, 0), cA, voffA); PG8_STAGE(PG8_SA(0, 1), cA + hstepA, voffA);
    if (wr == 1) PG8_BAR;
    PG8_WAIT_V(2); PG8_BAR;
    PG8_STAGE(PG8_SB(1, 0), cB + kstep, voffB); PG8_STAGE(PG8_SA(1, 0), cA + kstep, voffA); PG8_STAGE(PG8_SB(1, 1), cB + hstepB + kstep, voffB);
    PG8_WAIT_V(6); PG8_BAR;
    for (;;) {
        const bool has_next = S.next(ui + 1, nxt);
        const char* nA = has_next ? (const char*)g.A + (size_t)nxt.pm * tstepA : cA; const char* nB = has_next ? (const char*)g.Bt + (size_t)nxt.pn * tstepB : cB;
#pragma nounroll
        for (int t = 0; t < nt; t += 2) {
            const bool last = (t == nt - 2);
            const char* a1 = cA + (size_t)(t + 1) * kstep;
            const char* a2 = last ? nA : cA + (size_t)(t + 2) * kstep; const char* b2 = last ? nB : cB + (size_t)(t + 2) * kstep;
            const char* a3 = a2 + kstep; const char* b3 = b2 + kstep;
            if (last && has_next) E.prep(nxt, ui + 1, lds, tid);
            PG8_LDB(B0, 0, 0); PG8_LDB(B1, 0, 1); PG8_SCHED; PG8_LDA(At, 0, 0); PG8_STAGE(PG8_SA(1, 1), a1 + hstepA, voffA);
            PG8_WAIT_V(8); PG8_WAIT_L(0); PG8_BAR; PG8_MMA(0, 0, At, B0); PG8_MMA(0, 1, At, B1); PG8_BAR; PG8_SCHED;
            PG8_LDA(At, 0, 1); PG8_STAGE(PG8_SB(0, 0), b2, voffB); PG8_STAGE(PG8_SB(0, 1), b2 + hstepB, voffB); PG8_STAGE(PG8_SA(0, 0), a2, voffA);
            PG8_WAIT_V(8); PG8_WAIT_L(0); PG8_BAR; PG8_MMA(1, 0, At, B0); PG8_MMA(1, 1, At, B1); PG8_BAR; PG8_SCHED;
            PG8_LDB(B0, 1, 0); PG8_LDB(B1, 1, 1); PG8_SCHED; PG8_LDA(At, 1, 0); PG8_STAGE(PG8_SA(0, 1), a2 + hstepA, voffA);
            PG8_WAIT_V(8); PG8_WAIT_L(0); PG8_BAR; PG8_MMA(0, 0, At, B0); PG8_MMA(0, 1, At, B1); PG8_BAR; PG8_SCHED;
            PG8_LDA(At, 1, 1); PG8_STAGE(PG8_SB(1, 0), b3, voffB); PG8_STAGE(PG8_SB(1, 1), b3 + hstepB, voffB); PG8_STAGE(PG8_SA(1, 0), a3, voffA);
            PG8_WAIT_V(8); PG8_WAIT_L(0); PG8_BAR; PG8_MMA(1, 0, At, B0); PG8_MMA(1, 1, At, B1); PG8_BAR; PG8_SCHED;
        }
        if (wr == 0) PG8_BAR;
        E(acc, cur, ui, wr, wc, fr, fq, lds);
        if (!has_next) break;
#pragma unroll
        for (int a = 0; a < 2; ++a)
#pragma unroll
            for (int b = 0; b < 2; ++b)
#pragma unroll
                for (int m = 0; m < 4; ++m)
#pragma unroll
                    for (int n = 0; n < 2; ++n) acc[a][b][m][n] = (f32x4){0.f, 0.f, 0.f, 0.f};
        cur = nxt; cA = nA; cB = nB; ++ui;
        if (wr == 1) PG8_BAR;
    }
    PG8_WAIT_V(0);
    PG8_BAR;
#undef PG8_SA
#undef PG8_SB
#undef PG8_STAGE
#undef PG8_LDA
#undef PG8_LDB
#undef PG8_MMA
#undef PG8_WAIT_V
#undef PG8_WAIT_L
#undef PG8_BAR
#undef PG8_SCHED
}

typedef f32x4 Acc[2][2][4][2];
struct RowScale {
    const float* slab; int npart; float inv_n;
    __device__ __forceinline__ void fill(LAS unsigned char* lds, int ui, int row0, int tid) const {
        if (tid < 256) {
            const float* p = slab + (size_t)(row0 + tid) * npart; float s = 0.f;
            for (int i = 0; i < npart; i += 4) { const f32x4 v = *(const f32x4*)(p + i); s += (v[0] + v[1]) + (v[2] + v[3]); }
            ((LAS float*)(lds + TBL_OFF))[(ui & 1) * 256 + tid] = 1.0f / sqrtf(s * inv_n + EPS);
        }
    }
    __device__ __forceinline__ float get(LAS unsigned char* lds, int ui, int rl) const { return ((const LAS float*)(lds + TBL_OFF))[(ui & 1) * 256 + rl]; }
};
__device__ __forceinline__ float quad_row_sum(float s) { s += __shfl_xor(s, 16); s += __shfl_xor(s, 32); return s; }
__device__ __forceinline__ float sq8(const f32x4& a, const f32x4& b) { return (a[0] * a[0] + a[1] * a[1]) + (a[2] * a[2] + a[3] * a[3]) + (b[0] * b[0] + b[1] * b[1]) + (b[2] * b[2] + b[3] * b[3]); }
__device__ __forceinline__ u32x4 pack8(const f32x4& a, const f32x4& b) { u32x4 w; w.x = cvt_pk_bf16(a[0], a[1]); w.y = cvt_pk_bf16(a[2], a[3]); w.z = cvt_pk_bf16(b[0], b[1]); w.w = cvt_pk_bf16(b[2], b[3]); return w; }

template <bool SCALE, bool STATS> struct EpiBf16 {
    bf16_t* O; int ldc; RowScale rs; float* sq; float* skv; int st0;
    __device__ __forceinline__ void prep(const Unit& u, int ui, LAS unsigned char* lds, int tid) const { if (SCALE) rs.fill(lds, ui, u.pm * BM, tid); }
    __device__ __forceinline__ void operator()(const Acc& acc, const Unit& u, int ui, int wr, int wc, int fr, int fq, LAS unsigned char* lds) const {
        const int col0 = u.pn * BM + wc * 32 + 8 * fq;
        const int st = STATS ? (u.pn - st0) : -1;
#pragma unroll
        for (int ai = 0; ai < 2; ++ai)
#pragma unroll
            for (int m = 0; m < 4; ++m) {
                const int rl = ai * HALF + wr * 64 + m * 16 + fr; const size_t row = (size_t)u.pm * BM + rl;
                const float s = SCALE ? rs.get(lds, ui, rl) : 1.f;
                bf16_t* rowp = O + row * ldc + col0; float ss = 0.f;
#pragma unroll
                for (int bj = 0; bj < 2; ++bj) { const f32x4 v0 = acc[ai][bj][m][0] * s, v1 = acc[ai][bj][m][1] * s;
                    if (STATS) ss += sq8(v0, v1);
                    *(u32x4*)(rowp + bj * HALF) = pack8(v0, v1); }
                if (STATS) { if (st >= 0 && st < 3) { ss = quad_row_sum(ss); if (fq == 0) { if (st < 2) sq[row * 8 + st * 4 + wc] = ss; else skv[row * 4 + wc] = ss; } } }
            }
    }
};
struct EpiRes1 {
    const float* xinA; const float* xinB; int split;
    float* out; int row_off; bf16_t* xb; float* slab;
    __device__ __forceinline__ void prep(const Unit&, int, LAS unsigned char*, int) const {}
    __device__ __forceinline__ void operator()(const Acc& acc, const Unit& u, int ui, int wr, int wc, int fr, int fq, LAS unsigned char* lds) const {
        const int col0 = u.pn * BM + wc * 32 + 8 * fq;
        const int g0 = row_off + u.pm * BM;
        const float* xin = (g0 < split) ? xinA + (size_t)g0 * DM : xinB + (size_t)(g0 - split) * DM;
#pragma unroll
        for (int ai = 0; ai < 2; ++ai)
#pragma unroll
            for (int m = 0; m < 4; ++m) {
                const int rl = ai * HALF + wr * 64 + m * 16 + fr; const size_t row = (size_t)u.pm * BM + rl;
                float ss = 0.f;
#pragma unroll
                for (int bj = 0; bj < 2; ++bj) { const size_t co = (size_t)rl * DM + col0 + bj * HALF;
                    const f32x4 x0 = *(const f32x4*)(xin + co), x1 = *(const f32x4*)(xin + co + 4);
                    const f32x4 v0 = acc[ai][bj][m][0] + x0, v1 = acc[ai][bj][m][1] + x1;
                    float* op = out + (size_t)(g0 + rl) * DM + col0 + bj * HALF;
                    *(f32x4*)op = v0; *(f32x4*)(op + 4) = v1;
                    ss += sq8(v0, v1);
                    *(u32x4*)(xb + row * DM + col0 + bj * HALF) = pack8(v0, v1); }
                ss = quad_row_sum(ss); if (fq == 0) slab[row * 32 + u.pn * 4 + wc] = ss;
            }
    }
};
struct EpiGate {
    float* out; int row_off; const bf16_t* pe; bf16_t* xbn; float* slab; RowScale rs;
    __device__ __forceinline__ void prep(const Unit& u, int ui, LAS unsigned char* lds, int tid) const { rs.fill(lds, ui, u.pm * BM, tid); }
    __device__ __forceinline__ void operator()(const Acc& acc, const Unit& u, int ui, int wr, int wc, int fr, int fq, LAS unsigned char* lds) const {
        const int col0 = u.pn * BM + wc * 32 + 8 * fq;
        const int g0 = row_off + u.pm * BM;
#pragma unroll
        for (int ai = 0; ai < 2; ++ai)
#pragma unroll
            for (int m = 0; m < 4; ++m) {
                const int rl = ai * HALF + wr * 64 + m * 16 + fr; const size_t row = (size_t)u.pm * BM + rl;
                const float s = rs.get(lds, ui, rl) * -1.4426950408889634f; float ss = 0.f;
#pragma unroll
                for (int bj = 0; bj < 2; ++bj) { float* op = out + (size_t)(g0 + rl) * DM + col0 + bj * HALF;
                    const f32x4 x0 = *(const f32x4*)op, x1 = *(const f32x4*)(op + 4);
                    const u32x4 pw = *(const u32x4*)(pe + row * DM + col0 + bj * HALF);
                    const f32x4 p0 = {bf_lo(pw.x), bf_hi(pw.x), bf_lo(pw.y), bf_hi(pw.y)}, p1 = {bf_lo(pw.z), bf_hi(pw.z), bf_lo(pw.w), bf_hi(pw.w)};
                    f32x4 v0, v1;
#pragma unroll
                    for (int e = 0; e < 4; ++e) { const float g0_ = __builtin_amdgcn_rcpf(1.f + __builtin_amdgcn_exp2f(acc[ai][bj][m][0][e] * s)), g1_ = __builtin_amdgcn_rcpf(1.f + __builtin_amdgcn_exp2f(acc[ai][bj][m][1][e] * s));
                        v0[e] = x0[e] + p0[e] * g0_; v1[e] = x1[e] + p1[e] * g1_; }
                    *(f32x4*)op = v0; *(f32x4*)(op + 4) = v1;
                    ss += sq8(v0, v1);
                    *(u32x4*)(xbn + row * DM + col0 + bj * HALF) = pack8(v0, v1); }
                ss = quad_row_sum(ss); if (fq == 0) slab[row * 32 + u.pn * 4 + wc] = ss;
            }
    }
};
}

namespace att {
constexpr float LOG2E = 1.4426950408889634f;
constexpr float THR = 6.f;
__device__ __forceinline__ int crow(int r, int hi) { return (r & 3) + 8 * (r >> 2) + 4 * hi; }
template <int KIND> struct Cfg;
template <> struct Cfg<0> { static constexpr int NDQ = 12, NDV = 4, H = 6; static constexpr float SCALE = 0.07216878364870323f; };
template <> struct Cfg<1> { static constexpr int NDQ = 4, NDV = 2, H = 12; static constexpr float SCALE = 0.125f; };
template <> struct Cfg<2> { static constexpr int NDQ = 4, NDV = 2, H = 8; static constexpr float SCALE = 0.125f; };

struct Ctx {
    bf16_t* proj; const bf16_t* q; const bf16_t* kv;
    const f32x2* ropeT; const f32x2* rowT; const f32x2* colT;
    const float* gq_norm; const float* rpb;
};

template <int NDV> __device__ __forceinline__ int v_st(int k, int c) { const int kk = (k & ~0xC) | ((k & 4) << 1) | ((k & 8) >> 1); return ((kk >> 3) * NDV + (c >> 5)) * 512 + ((kk & 7) * 32 + (c & 31)) * 2; }
__device__ __forceinline__ int v_rd_base(int lane) { return ((lane & 3) << 3) | (((lane >> 2) & 3) << 6) | (((lane >> 4) & 1) << 5) | (((lane >> 5) & 1) << 8); }
template <int OFF> __device__ __forceinline__ s16x4 tr_read(unsigned vb) { s16x4 r; asm volatile("ds_read_b64_tr_b16 %0, %1 offset:%2" : "=&v"(r) : "v"(vb), "i"(OFF) : "memory"); return r; }

template <int C1000> struct Dummy {};
template <int KIND> __device__ __forceinline__ void softmax_tile(f32x16& p0, f32x16& p1, float& m_reg, float& l_reg, float& alpha, bf16x8& pa0, bf16x8& pa1, bf16x8& pa2, bf16x8& pa3) {
    constexpr float SC = Cfg<KIND>::SCALE, C = SC * LOG2E;
    float pmax = p0[0];
#pragma unroll
    for (int r = 1; r < 16; ++r) pmax = fmaxf(pmax, p0[r]);
#pragma unroll
    for (int r = 0; r < 16; ++r) pmax = fmaxf(pmax, p1[r]);
    { auto rr = __builtin_amdgcn_permlane32_swap(__float_as_uint(pmax), __float_as_uint(pmax), false, false);
      pmax = fmaxf(__uint_as_float(rr[0]), __uint_as_float(rr[1])); }
    float mn;
    if (__builtin_expect(__all(pmax - m_reg <= THR / SC), 1)) { mn = m_reg; alpha = 1.f; }
    else { mn = fmaxf(m_reg, pmax); alpha = __builtin_amdgcn_exp2f((m_reg - mn) * C); m_reg = mn; }
    const float mnC = -mn * C;
#pragma unroll
    for (int r = 0; r < 16; ++r) { p0[r] = __builtin_amdgcn_exp2f(fmaf(p0[r], C, mnC)); p1[r] = __builtin_amdgcn_exp2f(fmaf(p1[r], C, mnC)); }
    float ps = 0.f;
#pragma unroll
    for (int r = 0; r < 16; ++r) ps += p0[r];
#pragma unroll
    for (int r = 0; r < 16; ++r) ps += p1[r];
    { auto rr = __builtin_amdgcn_permlane32_swap(__float_as_uint(ps), __float_as_uint(ps), false, false);
      ps = __uint_as_float(rr[0]) + __uint_as_float(rr[1]); }
    l_reg = l_reg * alpha + ps;
#define PK4(P, BASE, OUT) do { unsigned a0 = cvt_pk_bf16(P[BASE + 0], P[BASE + 1]), a1 = cvt_pk_bf16(P[BASE + 2], P[BASE + 3]);   \
    unsigned b0 = cvt_pk_bf16(P[BASE + 4], P[BASE + 5]), b1 = cvt_pk_bf16(P[BASE + 6], P[BASE + 7]);                              \
    auto r0 = __builtin_amdgcn_permlane32_swap(a0, b0, false, false); auto r1 = __builtin_amdgcn_permlane32_swap(a1, b1, false, false); \
    u32x4 w = {r0[0], r1[0], r0[1], r1[1]}; OUT = __builtin_bit_cast(bf16x8, w); } while (0)
    PK4(p0, 0, pa0); PK4(p0, 8, pa1); PK4(p1, 0, pa2); PK4(p1, 8, pa3);
#undef PK4
}
template <int NDQ> __device__ __forceinline__ void qkt(f32x16& p0, f32x16& p1, const LAS unsigned char* Kb, const bf16x8* qr, int r32, int hi) {
    p0 = f32x16{}; p1 = f32x16{};
    const LAS unsigned char* kp = Kb + hi * 1040 + r32 * 16;
#pragma unroll
    for (int d0 = 0; d0 < NDQ; ++d0) {
        const bf16x8 b0 = *(const LAS bf16x8*)(kp + d0 * 2080);
        const bf16x8 b1 = *(const LAS bf16x8*)(kp + d0 * 2080 + 512);
        p0 = __builtin_amdgcn_mfma_f32_32x32x16_bf16(b0, qr[d0], p0, 0, 0, 0);
        p1 = __builtin_amdgcn_mfma_f32_32x32x16_bf16(b1, qr[d0], p1, 0, 0, 0); }
}
template <int NDV, int D0> __device__ __forceinline__ void pv_one(f32x16& od, unsigned vb, bf16x8 pa0, bf16x8 pa1, bf16x8 pa2, bf16x8 pa3) {
    constexpr int KS = NDV * 1024, HF = NDV * 512;
    const s16x4 l0 = tr_read<D0 * 512 + 0 * KS>(vb), h0 = tr_read<D0 * 512 + 0 * KS + HF>(vb), l1 = tr_read<D0 * 512 + 1 * KS>(vb), h1 = tr_read<D0 * 512 + 1 * KS + HF>(vb);
    const s16x4 l2 = tr_read<D0 * 512 + 2 * KS>(vb), h2 = tr_read<D0 * 512 + 2 * KS + HF>(vb), l3 = tr_read<D0 * 512 + 3 * KS>(vb), h3 = tr_read<D0 * 512 + 3 * KS + HF>(vb);
    asm volatile("s_waitcnt lgkmcnt(0)" ::: "memory"); SBAR();
#define PK(L, H) (bf16x8){L[0], L[1], L[2], L[3], H[0], H[1], H[2], H[3]}
    od = __builtin_amdgcn_mfma_f32_32x32x16_bf16(pa0, PK(l0, h0), od, 0, 0, 0);
    od = __builtin_amdgcn_mfma_f32_32x32x16_bf16(pa1, PK(l1, h1), od, 0, 0, 0);
    od = __builtin_amdgcn_mfma_f32_32x32x16_bf16(pa2, PK(l2, h2), od, 0, 0, 0);
    od = __builtin_amdgcn_mfma_f32_32x32x16_bf16(pa3, PK(l3, h3), od, 0, 0, 0);
#undef PK
}

template <int KIND> __device__ __forceinline__ void attn_unit(const Ctx& c, int s0, int slen, int h, int qb, LAS unsigned char* lds) {
    constexpr int NDQ = Cfg<KIND>::NDQ, NDV = Cfg<KIND>::NDV, KB = 2 * NDQ * 1040, VB = NDV * 4096;
    constexpr float SC = Cfg<KIND>::SCALE;
    const int tid = opaque_tid(), lane = tid & 63, r32 = lane & 31, hi = lane >> 5;
    const int wid = __builtin_amdgcn_readfirstlane(tid >> 6);
    LAS unsigned char* Kl = lds + A_KOFF; LAS unsigned char* Vl = lds + A_VOFF;
    LAS float* wsf = (LAS float*)(lds + A_WSOFF) + wid * 64;
    LAS float* bl = (LAS float*)(lds + A_BOFF);
    const int tq = qb * 256 + wid * 32 + r32;
    const size_t Rq = (size_t)(s0 + tq);
    int NT, kt0; int rsw = 0, rq = 0, cq = 0, csq = 0;
    if (KIND == 2) {
        const int rows = slen >> 6, r0 = qb * 4;
        const int lo = min(max(r0 - 4, 0), rows - 8), hi_r = min(max(r0 + 3 - 4, 0), rows - 8) + 7;
        NT = hi_r - lo + 1; kt0 = lo * 64;
        rq = r0 + (wid >> 1); rsw = min(max(rq - 4, 0), rows - 8);
        cq = 32 * (wid & 1) + r32; csq = min(max(cq - 8, 0), 48);
        for (int i = tid; i < 15 * 32; i += 512) { const int di = i >> 5, dj = i & 31; bl[i] = (dj < 31) ? c.rpb[(h * 15 + di) * 31 + dj] * (1.0f / SC) : 0.f; }
    } else { NT = slen >> 6; kt0 = 0; }
    bf16x8 qr[NDQ];
    if (KIND == 0) {
        const bf16_t* qp = c.q + Rq * LDQ + h * 192 + hi * 8;
#pragma unroll
        for (int d0 = 0; d0 < 12; ++d0) qr[d0] = *(const bf16x8*)(qp + d0 * 16);
        const f32x2* tb = c.ropeT + (size_t)tq * 32 + hi * 8;
#pragma unroll
        for (int a = 0; a < 2; ++a) {
            unsigned w1[4], w2[4];
#pragma unroll
            for (int i = 0; i < 8; i += 2) {
                const f32x2 cs0 = tb[a * 16 + i], cs1 = tb[a * 16 + i + 1];
                const float x10 = bf2f(qr[8 + a][i]), x11 = bf2f(qr[8 + a][i + 1]), x20 = bf2f(qr[10 + a][i]), x21 = bf2f(qr[10 + a][i + 1]);
                w1[i >> 1] = cvt_pk_bf16(x10 * cs0.x - x20 * cs0.y, x11 * cs1.x - x21 * cs1.y);
                w2[i >> 1] = cvt_pk_bf16(x20 * cs0.x + x10 * cs0.y, x21 * cs1.x + x11 * cs1.y);
            }
            qr[8 + a] = __builtin_bit_cast(bf16x8, (u32x4){w1[0], w1[1], w1[2], w1[3]});
            qr[10 + a] = __builtin_bit_cast(bf16x8, (u32x4){w2[0], w2[1], w2[2], w2[3]});
        }
    } else if (KIND == 1) {
        const bf16_t* qp = c.proj + Rq * LDP + C_GQ + h * 64 + hi * 8;
        float x[4][8]; float ss = 0.f;
#pragma unroll
        for (int d0 = 0; d0 < 4; ++d0) { const bf16x8 v = *(const bf16x8*)(qp + d0 * 16);
#pragma unroll
            for (int i = 0; i < 8; ++i) { x[d0][i] = bf2f(v[i]); ss += x[d0][i] * x[d0][i]; } }
        ss += __shfl_xor(ss, 32);
        const float rstd = 1.0f / sqrtf(ss * (1.0f / 64.0f) + EPS);
#pragma unroll
        for (int d0 = 0; d0 < 4; ++d0)
#pragma unroll
            for (int i = 0; i < 8; ++i) x[d0][i] *= rstd * c.gq_norm[d0 * 16 + hi * 8 + i];
        const f32x2* tr = c.rowT + (tq >> 6) * 16 + hi * 8; const f32x2* tc = c.colT + (tq & 63) * 16 + hi * 8;
#pragma unroll
        for (int a = 0; a < 2; ++a) {
            unsigned w1[4], w2[4];
#pragma unroll
            for (int i = 0; i < 8; i += 2) {
                const f32x2 cs0 = a ? tc[i] : tr[i], cs1 = a ? tc[i + 1] : tr[i + 1];
                const float x10 = x[2 * a][i], x11 = x[2 * a][i + 1], x20 = x[2 * a + 1][i], x21 = x[2 * a + 1][i + 1];
                w1[i >> 1] = cvt_pk_bf16(x10 * cs0.x - x20 * cs0.y, x11 * cs1.x - x21 * cs1.y);
                w2[i >> 1] = cvt_pk_bf16(x20 * cs0.x + x10 * cs0.y, x21 * cs1.x + x11 * cs1.y);
            }
            qr[2 * a] = __builtin_bit_cast(bf16x8, (u32x4){w1[0], w1[1], w1[2], w1[3]});
            qr[2 * a + 1] = __builtin_bit_cast(bf16x8, (u32x4){w2[0], w2[1], w2[2], w2[3]});
        }
    } else {
        const bf16_t* qp = c.proj + Rq * LDP + C_NAQ + h * 64 + hi * 8;
#pragma unroll
        for (int d0 = 0; d0 < 4; ++d0) qr[d0] = *(const bf16x8*)(qp + d0 * 16);
    }
    const size_t krow0 = (size_t)(s0 + kt0);
    const bf16_t *gk0, *gk1 = nullptr, *gk2 = nullptr, *gv0, *gv1 = nullptr;
    int lk0, lk1 = 0, lk2 = 0, lv0, lv1 = 0; size_t kstride, vstride, k2stride = 0;
    if (KIND == 0) {
        const int ka = tid >> 4, ca = tid & 15, kb2 = 32 + ka;
        gk0 = c.kv + (krow0 + ka) * LDKV + h * 256 + ca * 8; gk1 = c.kv + (krow0 + kb2) * LDKV + h * 256 + ca * 8; kstride = (size_t)64 * LDKV;
        lk0 = ca * 1040 + ka * 16; lk1 = ca * 1040 + kb2 * 16;
        const int kr = tid >> 3, cr = tid & 7;
        gk2 = c.proj + (krow0 + kr) * LDP + C_KR + cr * 8; k2stride = (size_t)64 * LDP; lk2 = (16 + cr) * 1040 + kr * 16;
        gv0 = c.kv + (krow0 + ka) * LDKV + h * 256 + 128 + ca * 8; gv1 = c.kv + (krow0 + kb2) * LDKV + h * 256 + 128 + ca * 8; vstride = (size_t)64 * LDKV;
        lv0 = v_st<NDV>(ka, ca * 8); lv1 = v_st<NDV>(kb2, ca * 8);
    } else {
        const int kr = tid >> 3, cr = tid & 7;
        const int kcol = (KIND == 1) ? C_GK + (h / 3) * 64 : C_NAK + h * 64, vcol = (KIND == 1) ? C_GV + (h / 3) * 64 : C_NAV + h * 64;
        gk0 = c.proj + (krow0 + kr) * LDP + kcol + cr * 8; gv0 = c.proj + (krow0 + kr) * LDP + vcol + cr * 8; kstride = vstride = (size_t)64 * LDP;
        lk0 = cr * 1040 + kr * 16; lv0 = v_st<NDV>(kr, cr * 8);
    }
    bf16x8 sk0, sk1, sk2, sv0, sv1;
#define SLOAD(j) do { sk0 = *(const bf16x8*)(gk0 + (size_t)(j) * kstride); sv0 = *(const bf16x8*)(gv0 + (size_t)(j) * vstride); \
        if (KIND == 0) { sk1 = *(const bf16x8*)(gk1 + (size_t)(j) * kstride); sk2 = *(const bf16x8*)(gk2 + (size_t)(j) * k2stride); sv1 = *(const bf16x8*)(gv1 + (size_t)(j) * vstride); } } while (0)
#define SWRITE(b) do { *(LAS bf16x8*)(Kl + (b) * KB + lk0) = sk0; *(LAS bf16x8*)(Vl + (b) * VB + lv0) = sv0; \
        if (KIND == 0) { *(LAS bf16x8*)(Kl + (b) * KB + lk1) = sk1; *(LAS bf16x8*)(Kl + (b) * KB + lk2) = sk2; *(LAS bf16x8*)(Vl + (b) * VB + lv1) = sv1; } } while (0)
    const unsigned vb0 = (unsigned)(uintptr_t)Vl + (unsigned)v_rd_base(lane);
    float m_reg = -1e30f, l_reg = 0.f; f32x16 o[NDV];
#pragma unroll
    for (int d = 0; d < NDV; ++d) o[d] = f32x16{};
    SLOAD(0); SWRITE(0); if (NT > 1) SLOAD(1);
    __syncthreads();
    for (int j = 0; j < NT; ++j) {
        const int b = j & 1;
        if (j + 1 < NT) SWRITE(b ^ 1);
        if (j + 2 < NT) SLOAD(j + 2);
        bool act = true; int di = 0;
        if (KIND == 2) { const int kr = (kt0 >> 6) + j; act = (kr >= rsw) && (kr < rsw + 8); di = kr - rq + 7; }
        if (act) {
            f32x16 p0, p1; bf16x8 pa0, pa1, pa2, pa3; float alpha;
            qkt<NDQ>(p0, p1, Kl + b * KB, qr, r32, hi);
            if (KIND == 2) {
                const LAS float* br = bl + di * 32 + (15 - cq);
#pragma unroll
                for (int r = 0; r < 16; ++r) { const int k0_ = crow(r, hi), k1_ = 32 + k0_;
                    const bool v0 = (k0_ >= csq) && (k0_ < csq + 16), v1 = (k1_ >= csq) && (k1_ < csq + 16);
                    const float b0_ = br[v0 ? k0_ : cq], b1_ = br[v1 ? k1_ : cq];
                    p0[r] = v0 ? p0[r] + b0_ : -INFINITY; p1[r] = v1 ? p1[r] + b1_ : -INFINITY; }
            }
            softmax_tile<KIND>(p0, p1, m_reg, l_reg, alpha, pa0, pa1, pa2, pa3);
            if (__any(alpha < 1.f)) { if (hi == 0) wsf[r32] = alpha; LDS_WAIT();
#pragma unroll
                for (int d = 0; d < NDV; ++d)
#pragma unroll
                    for (int r = 0; r < 16; ++r) o[d][r] *= wsf[crow(r, hi)];
                LDS_WAIT(); }
            SBAR();
            const unsigned vb = vb0 + (unsigned)(b * VB);
            pv_one<NDV, 0>(o[0], vb, pa0, pa1, pa2, pa3); pv_one<NDV, 1>(o[1], vb, pa0, pa1, pa2, pa3);
            if (NDV == 4) { pv_one<NDV, 2>(o[NDV - 2], vb, pa0, pa1, pa2, pa3); pv_one<NDV, 3>(o[NDV - 1], vb, pa0, pa1, pa2, pa3); }
        }
        __syncthreads();
    }
#undef SLOAD
#undef SWRITE
    if (hi == 0) wsf[32 + r32] = l_reg; LDS_WAIT();
    const int ocol = (KIND == 0) ? C_MLAG + h * 128 : (KIND == 1) ? C_GQ + h * 64 : C_NAQ + h * 64;
    const int gcol = (KIND == 0) ? C_MLAG + h * 128 : (KIND == 1) ? C_GQG + h * 64 : C_NAG + h * 64;
    bf16_t* obase = c.proj + (size_t)(s0 + qb * 256 + wid * 32) * LDP;
#pragma unroll
    for (int r = 0; r < 16; ++r) { const int orow = crow(r, hi); const float rl = __builtin_amdgcn_rcpf(wsf[32 + orow]);
#pragma unroll
        for (int d0 = 0; d0 < NDV; ++d0) { const float gt = bf2f((short)obase[(size_t)orow * LDP + gcol + d0 * 32 + r32]);
            const float y = o[d0][r] * rl * gt * __builtin_amdgcn_rcpf(1.f + __builtin_amdgcn_exp2f(-gt * LOG2E));
            obase[(size_t)orow * LDP + ocol + d0 * 32 + r32] = (bf16_t)(cvt_pk_bf16(y, 0.f) & 0xffffu); } }
    LDS_WAIT();
    __syncthreads();
}
}

#define XB_TMO      128
#define XB_XCNT(j)  (256  + 64 * (j))
#define XB_XSUB(j)  (1280 + 64 * (j))
#define XB_XGEN(j)  (2304 + 64 * (j))
#define XB_TOP      3328
#define XB_TOPGEN   3392
#define XCD_BAR_WORDS 3456
#define XB_SPIN_CAP (1u << 20)
__device__ __forceinline__ unsigned xb_ld(unsigned* p)              { return __hip_atomic_load(p, __ATOMIC_RELAXED, __HIP_MEMORY_SCOPE_AGENT); }
__device__ __forceinline__ unsigned xb_add(unsigned* p, unsigned v) { return __hip_atomic_fetch_add(p, v, __ATOMIC_RELAXED, __HIP_MEMORY_SCOPE_AGENT); }
__device__ __forceinline__ unsigned xb_xcc_id() { return (unsigned)__builtin_amdgcn_s_getreg((3 << 11) | 20) & 0xFu; }
#define XB_SPIN(cond, bar) do { unsigned _sp = 0; while (cond) { __builtin_amdgcn_s_sleep(1); \
    if ((++_sp & 255u) == 0u) { if (xb_ld(&(bar)[XB_TMO])) break; if (_sp > XB_SPIN_CAP) { atomicAdd(&(bar)[XB_TMO], 1u); break; } } } } while (0)
struct XcdBarrier { unsigned* bar; unsigned x; volatile LAS unsigned* st; };
__device__ __forceinline__ XcdBarrier xcd_barrier_post(unsigned* bar, volatile LAS unsigned* st) {
    XcdBarrier b; b.bar = bar; b.x = xb_xcc_id(); b.st = st;
    if (threadIdx.x == 0) (void)xb_add(&bar[XB_XCNT(b.x)], 1u);
    return b;
}
__device__ __forceinline__ void xcd_barrier_complete(unsigned* bar, unsigned x, unsigned& nloc, unsigned& nx) {
    const unsigned G = gridDim.x * gridDim.y * gridDim.z;
    unsigned sum, cnt, mine, sp = 0u;
    for (;;) {
        sum = 0u; cnt = 0u; mine = 0u;
#pragma unroll
        for (unsigned j = 0; j < 16; ++j) { const unsigned c = xb_ld(&bar[XB_XCNT(j)]); sum += c; cnt += (c > 0u) ? 1u : 0u; mine = (j == x) ? c : mine; }
        if (sum == G) break;
        __builtin_amdgcn_s_sleep(1);
        if ((++sp & 255u) == 0u) { if (xb_ld(&bar[XB_TMO])) break; if (sp > XB_SPIN_CAP) { atomicAdd(&bar[XB_TMO], 1u); break; } }
    }
    nloc = mine > 0u ? mine : 1u; nx = cnt > 0u ? cnt : 1u;
}
__device__ __forceinline__ void xcd_barrier(const XcdBarrier& b) {
    asm volatile("s_waitcnt vmcnt(0)" ::: "memory");
    __syncthreads();
    if (threadIdx.x == 0) {
        unsigned* bar = b.bar;
        __builtin_amdgcn_s_waitcnt(0);
        unsigned nloc = b.st[0], nx = b.st[1];
        if (nloc == 0u) { xcd_barrier_complete(bar, b.x, nloc, nx); b.st[0] = nloc; b.st[1] = nx; }
        const unsigned old = xb_add(&bar[XB_XSUB(b.x)], 1u);
        const unsigned gen = old / nloc;
        if (old + 1u == (gen + 1u) * nloc) {
            __builtin_amdgcn_fence(__ATOMIC_RELEASE, "agent");
            asm volatile("s_waitcnt vmcnt(0)" ::: "memory");
            const unsigned og = xb_add(&bar[XB_TOP], 1u);
            const unsigned tg = og / nx;
            if (og + 1u == (tg + 1u) * nx) xb_add(&bar[XB_TOPGEN], 1u);
            else XB_SPIN(xb_ld(&bar[XB_TOPGEN]) == tg, bar);
            __builtin_amdgcn_fence(__ATOMIC_ACQUIRE, "agent");
            xb_add(&bar[XB_XGEN(b.x)], 1u);
            asm volatile("s_waitcnt vmcnt(0)" ::: "memory");
        } else {
            XB_SPIN(xb_ld(&bar[XB_XGEN(b.x)]) == gen, bar);
            __builtin_amdgcn_fence(__ATOMIC_ACQUIRE, "agent");
            asm volatile("s_waitcnt vmcnt(0)" ::: "memory");
        }
    }
    __syncthreads();
}

struct Args {
    const float* xp; const float* xs; const float* pp; const float* ps; const float* norm_g; const float* w_in; const float* na_rpb; const float* q_a_norm; const float* w_q_b;
    const float* kv_a_norm; const float* w_kv_b; const float* gq_norm; const float* gk_norm; const float* w_out; const float* ple_norm; const float* w_pe; const float* w_pg; const float* final_norm;
    float* out; unsigned char* ws; int ph_lo, ph_hi;
};
constexpr int NPHASE = 24;

__device__ __forceinline__ const float* x_row(const Args& a, int grow) { return grow < SEQ_P ? a.xp + (size_t)grow * DM : a.xs + (size_t)(grow - SEQ_P) * DM; }

__device__ __forceinline__ void tr_item(const float* W, int Nsrc, int n_src0, const float* gain, bf16_t* WT, int K, int k0, int n_dst0, bool zero, LAS float* scr, int lane) {
#pragma unroll 8
    for (int i = 0; i < 32; ++i) { const int kk = 2 * i + (lane >> 5); float w = 0.f;
        if (!zero) { w = W[(size_t)(k0 + kk) * Nsrc + n_src0 + (lane & 31)]; if (gain) w *= gain[k0 + kk]; }
        scr[kk * 33 + (lane & 31)] = w; }
    LDS_WAIT(); asm volatile("" ::: "memory");
    const int cc = lane & 7;
#pragma unroll
    for (int j = 0; j < 4; ++j) { const int n = (lane >> 3) + 8 * j; const LAS float* s = scr + (8 * cc) * 33 + n;
        u32x4 o; o.x = cvt_pk_bf16(s[0 * 33], s[1 * 33]); o.y = cvt_pk_bf16(s[2 * 33], s[3 * 33]); o.z = cvt_pk_bf16(s[4 * 33], s[5 * 33]); o.w = cvt_pk_bf16(s[6 * 33], s[7 * 33]);
        *(u32x4*)(WT + (size_t)(n_dst0 + n) * K + k0 + 8 * cc) = o; }
    LDS_WAIT(); asm volatile("" ::: "memory");
}
__device__ __forceinline__ int proj_src_col(int n) {
    if (n < C_MLAG) return n;
    if (n < C_GQ) return 2880 + (n - C_MLAG);
    if (n < C_NAK) return 3648 + (n - C_GQ);
    if (n < C_NAV) return 512 + (n - C_NAK);
    if (n < C_NAG) return 1024 + (n - C_NAV);
    if (n < C_CQ) return 1536 + (n - C_NAG);
    if (n < C_CKV) return 2048 + (n - C_CQ);
    if (n < C_GK) return 2560 + (n - C_CKV);
    if (n < C_GV) return 4416 + (n - C_GK);
    if (n < C_GQG) return 4672 + (n - C_GV);
    if (n < C_KR) return 4928 + (n - C_GQG);
    return 2816 + (n - C_KR);
}
__device__ __forceinline__ void sincos_d(double a, float& c, float& s) {
    const double k = __builtin_rint(a * 0.15915494309189535);
    double r = __builtin_fma(-k, 6.283185307179586, a); r = __builtin_fma(-k, 2.4492935982947064e-16, r);
    const double r2 = r * r; double sn = 1.0, cs = 1.0;
#pragma unroll
    for (int i = 12; i >= 1; --i) { sn = 1.0 - r2 * (1.0 / (double)((2 * i) * (2 * i + 1))) * sn; cs = 1.0 - r2 * (1.0 / (double)((2 * i - 1) * (2 * i))) * cs; }
    s = (float)(r * sn); c = (float)cs;
}

__global__ void __launch_bounds__(512, 2) fwd(Args a) {
    extern __shared__ __attribute__((aligned(16))) unsigned char lds_raw[];
    LAS unsigned char* lds = (LAS unsigned char*)lds_raw;
    volatile LAS unsigned* MISC = (volatile LAS unsigned*)(lds + MISC_OFF);
    const int tid = threadIdx.x, lane = tid & 63, wave = __builtin_amdgcn_readfirstlane(tid >> 6);
    const int G = gridDim.x, bx = blockIdx.x;
    const int vcu = (G % 8 == 0) ? (bx % 8) * (G / 8) + bx / 8 : bx;
    unsigned char* ws = a.ws;
    gu32* ctl = (gu32*)(ws + WS_CTL);
    if (tid < 64) MISC[tid] = 0u;
    __syncthreads();
#if MK_PER_PHASE
#define GRID_BAR() do {} while (0)
#else
    XcdBarrier bar = xcd_barrier_post((unsigned*)ctl + CW_BAR, MISC);
#define GRID_BAR() xcd_barrier(bar)
#endif
    const int lo = a.ph_lo, hi = a.ph_hi;
#define IN(k) (lo <= (k) && (k) < hi)
#define SEAM(k) do { if (IN(k) && IN((k) + 1)) GRID_BAR(); } while (0)
    const int gw = vcu * 8 + wave, NGW = G * 8;
    bf16_t* W1t = (bf16_t*)(ws + WS_W1); bf16_t* Wqb = (bf16_t*)(ws + WS_WQB); bf16_t* Wkvb = (bf16_t*)(ws + WS_WKVB);
    bf16_t* Wout = (bf16_t*)(ws + WS_WOUT); bf16_t* Wpg = (bf16_t*)(ws + WS_WPG); bf16_t* Wpe = (bf16_t*)(ws + WS_WPE);
    f32x2* ropeT = (f32x2*)(ws + WS_ROPET); f32x2* rowT = (f32x2*)(ws + WS_ROWT); f32x2* colT = (f32x2*)(ws + WS_COLT);
    float* S1 = (float*)(ws + WS_S1); float* S2 = (float*)(ws + WS_S2); float* SQ = (float*)(ws + WS_SQ); float* SKV = (float*)(ws + WS_SKV);
    bf16_t* PB = (bf16_t*)(ws + WS_PB); bf16_t* XB0 = (bf16_t*)(ws + WS_XB0); bf16_t* XB1 = (bf16_t*)(ws + WS_XB1);
    bf16_t* PROJ = (bf16_t*)(ws + WS_PROJ); bf16_t* QB = (bf16_t*)(ws + WS_Q); bf16_t* KVB = (bf16_t*)(ws + WS_KV); bf16_t* PE = (bf16_t*)(ws + WS_PE);

    if (IN(0)) {
        const int tid = opaque_tid(), lane = tid & 63;
        LAS float* scr = (LAS float*)(lds + wave * 16384);
        constexpr int I_W1 = 32 * (LDP / 32), I_QB = 8 * (LDQ / 32), I_KVB = 4 * (LDKV / 32), I_SQ = 32 * 64, I_PE = 4 * 64;
        constexpr int I_L = I_W1 + I_QB + I_KVB + 2 * I_SQ + I_PE;
        for (int it = gw; it < 2 * I_L; it += NGW) {
            const int l = it / I_L; int r = it % I_L;
            if (r < I_W1) { const int nb = r % (LDP / 32), kb = r / (LDP / 32), n0 = nb * 32;
                tr_item(a.w_in + (size_t)l * DM * IN_COLS, IN_COLS, n0 < IN_COLS ? proj_src_col(n0) : 0, a.norm_g + l * DM, W1t + (size_t)l * LDP * DM, DM, kb * 64, n0, n0 >= IN_COLS, scr, lane); continue; }
            r -= I_W1;
            if (r < I_QB) { const int nb = r % (LDQ / 32), kb = r / (LDQ / 32), n0 = nb * 32;
                tr_item(a.w_q_b + (size_t)l * 512 * 1152, 1152, n0 < 1152 ? n0 : 0, a.q_a_norm + l * 512, Wqb + (size_t)l * LDQ * 512, 512, kb * 64, n0, n0 >= 1152, scr, lane); continue; }
            r -= I_QB;
            if (r < I_KVB) { const int nb = r % (LDKV / 32), kb = r / (LDKV / 32), n0 = nb * 32;
                tr_item(a.w_kv_b + (size_t)l * 256 * 1536, 1536, n0, a.kv_a_norm + l * 256, Wkvb + (size_t)l * LDKV * 256, 256, kb * 64, n0, false, scr, lane); continue; }
            r -= I_KVB;
            if (r < I_SQ) { const int nb = r % 64, kb = r / 64;
                tr_item(a.w_out + (size_t)l * DM * DM, DM, nb * 32, nullptr, Wout + (size_t)l * DM * DM, DM, kb * 64, nb * 32, false, scr, lane); continue; }
            r -= I_SQ;
            if (r < I_SQ) { const int nb = r % 64, kb = r / 64;
                tr_item(a.w_pg + (size_t)l * DM * DM, DM, nb * 32, a.ple_norm + l * DM, Wpg + (size_t)l * DM * DM, DM, kb * 64, nb * 32, false, scr, lane); continue; }
            r -= I_SQ;
            { const int nb = r % 64, kb = r / 64;
                tr_item(a.w_pe + (size_t)l * PLE * DM, DM, nb * 32, nullptr, Wpe + (size_t)l * DM * PLE, PLE, kb * 64, nb * 32, false, scr, lane); }
        }
        const double RB = 0.7498942093324558273;
        for (int i = (vcu * 512 + tid); i < SEQ_P * 32 + 256 * 16 + 64 * 16; i += G * 512) {
            int pos, j; double base; f32x2* dst;
            if (i < SEQ_P * 32) { pos = i >> 5; j = i & 31; base = RB; dst = ropeT + i; }
            else if (i < SEQ_P * 32 + 256 * 16) { const int k = i - SEQ_P * 32; pos = k >> 4; j = k & 15; base = RB * RB; dst = rowT + k; }
            else { const int k = i - SEQ_P * 32 - 256 * 16; pos = k >> 4; j = k & 15; base = RB * RB; dst = colT + k; }
            double inv = 1.0; for (int q = 0; q < j; ++q) inv *= base;
            float c_, s_; sincos_d((double)pos * inv, c_, s_);
            *dst = (f32x2){c_, s_};
        }
    }
    SEAM(0);

    for (int g = 0; g < 2; ++g) {
        const int row_off = g ? GROWS0 : 0, grows = g ? GROWS1 : GROWS0, nM = grows / 256;
        const int pbase = 1 + g * 11;
        if (IN(pbase)) {
            const int tid = opaque_tid(), lane = tid & 63; (void)tid;
            for (int r = gw; r < grows; r += NGW) {
                const f32x4* xr = (const f32x4*)x_row(a, row_off + r) + lane;
                f32x4 v[8]; float s = 0.f;
#pragma unroll
                for (int j = 0; j < 8; ++j) { v[j] = xr[64 * j]; s += (v[j][0] * v[j][0] + v[j][1] * v[j][1]) + (v[j][2] * v[j][2] + v[j][3] * v[j][3]); }
                s = wave_sum(s);
                u32x2* o8 = (u32x2*)(XB0 + (size_t)r * DM) + lane;
#pragma unroll
                for (int j = 0; j < 8; ++j) o8[64 * j] = (u32x2){cvt_pk_bf16(v[j][0], v[j][1]), cvt_pk_bf16(v[j][2], v[j][3])};
                if (lane < 32) S1[(size_t)r * 32 + lane] = (lane == 0) ? s : 0.f;
            }
            for (int it = gw; it < 2 * grows; it += NGW) {
                const int l = it / grows, r = it % grows, grow = row_off + r;
                const float* pr = grow < SEQ_P ? a.pp + ((size_t)l * SEQ_P + grow) * PLE : a.ps + ((size_t)l * (NTOK - SEQ_P) + (grow - SEQ_P)) * PLE;
                const f32x4 v = ((const f32x4*)pr)[lane];
                ((u32x2*)(PB + ((size_t)l * GMAX + r) * PLE))[lane] = (u32x2){cvt_pk_bf16(v[0], v[1]), cvt_pk_bf16(v[2], v[3])};
            }
        }
        SEAM(pbase);
        for (int l = 0; l < 2; ++l) {
            const int ph = pbase + 1 + l * 5;
            bf16_t* XBa = (l == 0) ? XB0 : XB1; bf16_t* XBb = (l == 0) ? XB1 : XB0;
            if (IN(ph)) {
                pg8::Gemm gm{XBa, W1t + (size_t)l * LDP * DM};
                pg8::StaticOrder S; S.init(nM, LDP / 256, G, bx);
                pg8::EpiBf16<true, true> E{PROJ, LDP, pg8::RowScale{S1, 32, 1.0f / DM}, SQ, SKV, TILE_CQ0};
                pg8::gemm_phase<DM, DM>(lds, gm, S, E);
            }
            SEAM(ph);
            if (IN(ph + 1)) {
                const int tid = opaque_tid(), lane = tid & 63; (void)tid;
                const float* gk = a.gk_norm + l * 64;
                for (int it = gw; it < grows / 2; it += NGW) {
                    const int r = it * 2 + (lane >> 5), hd = (lane >> 3) & 3, sub = lane & 7;
                    const int grow = row_off + r; const int t = grow < SEQ_P ? grow : (grow - SEQ_P) & (SEQ_S - 1);
                    bf16_t* p = PROJ + (size_t)r * LDP + C_GK + hd * 64 + sub * 8;
                    const bf16x8 v = *(const bf16x8*)p; float x[8], y[8]; float ss = 0.f;
#pragma unroll
                    for (int i = 0; i < 8; ++i) { x[i] = bf2f(v[i]); ss += x[i] * x[i]; }
                    ss += __shfl_xor(ss, 1); ss += __shfl_xor(ss, 2); ss += __shfl_xor(ss, 4);
                    const float rstd = 1.0f / sqrtf(ss * (1.0f / 64.0f) + EPS);
#pragma unroll
                    for (int i = 0; i < 8; ++i) x[i] *= rstd * gk[sub * 8 + i];
                    const f32x2* tb = (sub < 4 ? rowT + (t >> 6) * 16 : colT + (t & 63) * 16) + (sub & 1) * 8;
                    const bool second = (sub & 2) != 0;
#pragma unroll
                    for (int i = 0; i < 8; ++i) { const float o_ = __shfl_xor(x[i], 2); const f32x2 cs = tb[i]; y[i] = second ? x[i] * cs.x + o_ * cs.y : x[i] * cs.x - o_ * cs.y; }
                    *(u32x4*)p = (u32x4){cvt_pk_bf16(y[0], y[1]), cvt_pk_bf16(y[2], y[3]), cvt_pk_bf16(y[4], y[5]), cvt_pk_bf16(y[6], y[7])};
                }
                for (int it = gw; it < grows / 8; it += NGW) {
                    const int r = it * 8 + (lane >> 3), sub = lane & 7;
                    const int grow = row_off + r; const int t = grow < SEQ_P ? grow : (grow - SEQ_P) & (SEQ_S - 1);
                    bf16_t* p = PROJ + (size_t)r * LDP + C_KR + sub * 8;
                    const bf16x8 v = *(const bf16x8*)p; float x[8], y[8];
#pragma unroll
                    for (int i = 0; i < 8; ++i) x[i] = bf2f(v[i]);
                    const f32x2* tb = ropeT + (size_t)t * 32 + (sub & 3) * 8; const bool second = (sub & 4) != 0;
#pragma unroll
                    for (int i = 0; i < 8; ++i) { const float o_ = __shfl_xor(x[i], 4); const f32x2 cs = tb[i]; y[i] = second ? x[i] * cs.x + o_ * cs.y : x[i] * cs.x - o_ * cs.y; }
                    *(u32x4*)p = (u32x4){cvt_pk_bf16(y[0], y[1]), cvt_pk_bf16(y[2], y[3]), cvt_pk_bf16(y[4], y[5]), cvt_pk_bf16(y[6], y[7])};
                }
                VM_WAIT(); __syncthreads();
                { pg8::Gemm gm{PROJ + C_CQ, Wqb + (size_t)l * LDQ * 512};
                  pg8::StaticOrder S; S.init(nM, LDQ / 256, G, bx);
                  pg8::EpiBf16<true, false> E{QB, LDQ, pg8::RowScale{SQ, 8, 1.0f / 512}, nullptr, nullptr, 0};
                  pg8::gemm_phase<LDP, 512>(lds, gm, S, E); }
                { pg8::Gemm gm{PROJ + C_CKV, Wkvb + (size_t)l * LDKV * 256};
                  pg8::StaticOrder S; S.init(nM, LDKV / 256, G, bx);
                  pg8::EpiBf16<true, false> E{KVB, LDKV, pg8::RowScale{SKV, 4, 1.0f / 256}, nullptr, nullptr, 0};
                  pg8::gemm_phase<LDP, 256>(lds, gm, S, E); }
            }
            SEAM(ph + 1);
            if (IN(ph + 2)) {
                const int tid = opaque_tid();
                att::Ctx cx{PROJ, QB, KVB, ropeT, rowT, colT, a.gq_norm + l * 64, a.na_rpb + (size_t)l * 8 * 15 * 31};
                gu32* qh = ctl + CW_QUEUE + 64 * ((g * 2 + l) * 3);
#define ATT_LOOP(KIND) do { constexpr int H_ = att::Cfg<KIND>::H; const int total = (g == 0 ? 128 : 64) * H_; \
                for (;;) { if (tid == 0) MISC[4] = __hip_atomic_fetch_add(qh + 64 * KIND, 1u, __ATOMIC_RELAXED, __HIP_MEMORY_SCOPE_AGENT); \
                    __syncthreads(); const int idx = __builtin_amdgcn_readfirstlane((int)MISC[4]); __syncthreads(); \
                    if (idx >= total) break; \
                    int s0, slen, hh, qb; \
                    if (g == 0 && idx < 64 * H_) { s0 = 0; slen = SEQ_P; hh = idx >> 6; qb = idx & 63; } \
                    else { const int k = (g == 0) ? idx - 64 * H_ : idx; const int sq = k / (8 * H_), rem = k % (8 * H_); s0 = (g == 0 ? SEQ_P : 0) + sq * SEQ_S; slen = SEQ_S; hh = rem >> 3; qb = rem & 7; } \
                    att::attn_unit<KIND>(cx, s0, slen, hh, qb, lds); } } while (0)
                ATT_LOOP(0);
                ATT_LOOP(1);
                ATT_LOOP(2);
#undef ATT_LOOP
            }
            SEAM(ph + 2);
            if (IN(ph + 3)) {
                { pg8::Gemm gm{PROJ, Wout + (size_t)l * DM * DM};
                  pg8::StaticOrder S; S.init(nM, DM / 256, G, bx);
                  pg8::EpiRes1 E{l == 0 ? a.xp : a.out, l == 0 ? a.xs : a.out, l == 0 ? SEQ_P : 0x7fffffff, a.out, row_off, XBa, S2};
                  pg8::gemm_phase<LDP, DM>(lds, gm, S, E); }
                { pg8::Gemm gm{PB + (size_t)l * GMAX * PLE, Wpe + (size_t)l * DM * PLE};
                  pg8::StaticOrder S; S.init(nM, DM / 256, G, bx);
                  pg8::EpiBf16<false, false> E{PE, DM, pg8::RowScale{nullptr, 0, 0.f}, nullptr, nullptr, 0};
                  pg8::gemm_phase<PLE, PLE>(lds, gm, S, E); }
            }
            SEAM(ph + 3);
            if (IN(ph + 4)) {
                pg8::Gemm gm{XBa, Wpg + (size_t)l * DM * DM};
                pg8::StaticOrder S; S.init(nM, DM / 256, G, bx);
                pg8::EpiGate E{a.out, row_off, PE, XBb, S1, pg8::RowScale{S2, 32, 1.0f / DM}};
                pg8::gemm_phase<DM, DM>(lds, gm, S, E);
            }
            SEAM(ph + 4);
        }
        const int pf = (g == 0) ? 12 : 23;
        if (IN(pf)) {
            const int tid = opaque_tid(), lane = tid & 63; (void)tid;
            for (int r = gw; r < grows; r += NGW) {
                const f32x4 sv = ((const f32x4*)(S1 + (size_t)r * 32))[lane & 7];
                float s = (sv[0] + sv[1]) + (sv[2] + sv[3]); s += __shfl_xor(s, 1); s += __shfl_xor(s, 2); s += __shfl_xor(s, 4);
                const float rstd = 1.0f / sqrtf(s * (1.0f / DM) + EPS);
                f32x4* orow = (f32x4*)(a.out + (size_t)(row_off + r) * DM) + lane; const f32x4* fg = (const f32x4*)a.final_norm + lane;
#pragma unroll
                for (int j = 0; j < 8; ++j) { const f32x4 v = orow[64 * j], gg = fg[64 * j]; orow[64 * j] = v * rstd * gg; }
            }
            if (g == 0) { VM_WAIT(); __syncthreads(); }
        }
    }
#undef IN
#undef SEAM
#undef GRID_BAR
}

extern "C" void kernel_launch(void* const* d_in, const int* in_sizes, int n_in, void* d_out, int out_size, void* d_ws, size_t ws_size, hipStream_t stream) {
    static int grid = 0;
    if (grid == 0) {
        if (n_in != 18 || out_size != NTOK * DM || ws_size < WS_END) { fprintf(stderr, "kernel_launch: shape mismatch (n_in %d, out %d, ws %zu < %zu)\n", n_in, out_size, ws_size, (size_t)WS_END); grid = -1; return; }
        int dev = 0, cus = 0;
        if (hipGetDevice(&dev) != hipSuccess || hipDeviceGetAttribute(&cus, hipDeviceAttributeMultiprocessorCount, dev) != hipSuccess) { grid = -1; return; }
        if (hipFuncSetAttribute((const void*)fwd, hipFuncAttributeMaxDynamicSharedMemorySize, LDS_BYTES) != hipSuccess) { fprintf(stderr, "kernel_launch: hipFuncSetAttribute failed\n"); grid = -1; return; }
        int per_cu = 0;
        if (hipOccupancyMaxActiveBlocksPerMultiprocessor(&per_cu, (const void*)fwd, 512, LDS_BYTES) != hipSuccess || per_cu < 1) fprintf(stderr, "kernel_launch: occupancy query reports %d\n", per_cu);
        (void)hipGetLastError();
        grid = cus;
    }
    if (grid < 0) return;
    if (hipMemsetAsync((char*)d_ws + WS_CTL, 0, CTL_ZERO_BYTES, stream) != hipSuccess) return;
    Args a{};
    a.xp = (const float*)d_in[0]; a.xs = (const float*)d_in[1]; a.pp = (const float*)d_in[2]; a.ps = (const float*)d_in[3]; a.norm_g = (const float*)d_in[4]; a.w_in = (const float*)d_in[5];
    a.na_rpb = (const float*)d_in[6]; a.q_a_norm = (const float*)d_in[7]; a.w_q_b = (const float*)d_in[8]; a.kv_a_norm = (const float*)d_in[9]; a.w_kv_b = (const float*)d_in[10];
    a.gq_norm = (const float*)d_in[11]; a.gk_norm = (const float*)d_in[12]; a.w_out = (const float*)d_in[13]; a.ple_norm = (const float*)d_in[14]; a.w_pe = (const float*)d_in[15];
    a.w_pg = (const float*)d_in[16]; a.final_norm = (const float*)d_in[17];
    a.out = (float*)d_out; a.ws = (unsigned char*)d_ws;
#if MK_PER_PHASE
    for (int p = 0; p < NPHASE; ++p) { a.ph_lo = p; a.ph_hi = p + 1; hipLaunchKernelGGL(fwd, dim3(grid), dim3(512), LDS_BYTES, stream, a); }
#else
    a.ph_lo = 0; a.ph_hi = NPHASE; hipLaunchKernelGGL(fwd, dim3(grid), dim3(512), LDS_BYTES, stream, a);
#endif
    const hipError_t le = hipPeekAtLastError();
    if (le != hipSuccess) fprintf(stderr, "kernel_launch: launch failed: %s\n", hipGetErrorName(le));
}
```

```cpp
#include <hip/hip_runtime.h>
#include <cstdio>
#include <cstdint>

#ifndef MK_PER_PHASE
#define MK_PER_PHASE 0
#endif

#ifndef WGM_P1
#define WGM_P1 8
#endif
#ifndef WGM_SQ
#define WGM_SQ 2
#endif
#ifndef WGM_SM
#define WGM_SM 4
#endif
#ifndef PROBE
#define PROBE 0
#endif
#define LAS __attribute__((address_space(3)))
#define GAS __attribute__((address_space(1)))
typedef unsigned short bf16_t;
typedef short bf16x8 __attribute__((ext_vector_type(8)));
typedef short s16x4 __attribute__((ext_vector_type(4)));
typedef float f32x2 __attribute__((ext_vector_type(2)));
typedef float f32x4 __attribute__((ext_vector_type(4)));
typedef float f32x16 __attribute__((ext_vector_type(16)));
typedef unsigned u32x2 __attribute__((ext_vector_type(2)));
typedef unsigned u32x4 __attribute__((ext_vector_type(4)));
typedef GAS unsigned gu32;

constexpr int DM = 2048, NTOK = 49152, SEQ_P = 16384, SEQ_S = 2048, PLE = 256;
constexpr int IN_COLS = 5696, LDP = 5888;
constexpr int GROWS0 = 32768, GROWS1 = 16384, GMAX = 32768;
constexpr float EPS = 1e-6f;
constexpr int C_NAQ = 0, C_MLAG = 512, C_GQ = 1280, C_NAK = 2048, C_NAV = 2560, C_NAG = 3072, C_CQ = 3584, C_CKV = 4096, C_GK = 4352, C_GV = 4608, C_GQG = 4864, C_KR = 5632;
constexpr int LDQ = 1280, LDKV = 1536;
constexpr int TILE_CQ0 = C_CQ / 256, TILE_CKV = C_CKV / 256;

constexpr size_t MiB = 1u << 20;
constexpr size_t WS_CTL = 0, CTL_ZERO_BYTES = 1 * MiB;
constexpr size_t SZ_W1 = (size_t)LDP * DM * 2, SZ_WQB = (size_t)LDQ * 512 * 2, SZ_WKVB = (size_t)LDKV * 256 * 2, SZ_WSQ = (size_t)DM * DM * 2, SZ_WPE = (size_t)DM * PLE * 2;
constexpr size_t WS_W1 = 1 * MiB;
constexpr size_t WS_WQB = WS_W1 + 2 * SZ_W1;
constexpr size_t WS_WKVB = WS_WQB + 2 * SZ_WQB;
constexpr size_t WS_WOUT = WS_WKVB + 2 * SZ_WKVB;
constexpr size_t WS_WPG = WS_WOUT + 2 * SZ_WSQ;
constexpr size_t WS_WPE = WS_WPG + 2 * SZ_WSQ;
constexpr size_t WS_ROPET = WS_WPE + 2 * SZ_WPE;
constexpr size_t WS_ROWT = WS_ROPET + (size_t)SEQ_P * 32 * 8;
constexpr size_t WS_COLT = WS_ROWT + 256 * 16 * 8;
constexpr size_t WS_S1 = ((WS_COLT + 64 * 16 * 8 + 4095) / 4096) * 4096;
constexpr size_t WS_S2 = WS_S1 + (size_t)GMAX * 32 * 4;
constexpr size_t WS_SQ = WS_S2 + (size_t)GMAX * 32 * 4;
constexpr size_t WS_SKV = WS_SQ + (size_t)GMAX * 8 * 4;
constexpr size_t WS_PB = WS_SKV + (size_t)GMAX * 4 * 4;
constexpr size_t WS_XB0 = WS_PB + (size_t)2 * GMAX * PLE * 2;
constexpr size_t WS_XB1 = WS_XB0 + (size_t)GMAX * DM * 2;
constexpr size_t WS_PROJ = WS_XB1 + (size_t)GMAX * DM * 2;
constexpr size_t WS_Q = WS_PROJ + (size_t)GMAX * LDP * 2;
constexpr size_t WS_KV = WS_Q + (size_t)GMAX * LDQ * 2;
constexpr size_t WS_PE = WS_Q;
constexpr size_t WS_KN8 = WS_KV;
constexpr size_t WS_V8 = WS_KN8 + (size_t)GMAX * 768;
constexpr size_t WS_KR8 = WS_V8 + (size_t)GMAX * 768;
static_assert(WS_KR8 + (size_t)GMAX * 64 <= WS_KV + (size_t)GMAX * LDKV * 2, "fp8 MLA operands fit the KV region");
constexpr size_t WS_KF8 = WS_KV + (size_t)GMAX * LDKV * 2;
constexpr size_t WS_GV8 = WS_KF8 + (size_t)GMAX * 256;
constexpr size_t WS_END = WS_GV8 + (size_t)GMAX * 256;
static_assert(WS_PE + (size_t)GMAX * DM * 2 <= WS_END, "PE overlay fits Q|KV");
static_assert(WS_END <= (size_t)1024 * MiB, "workspace map fits 1 GiB");
constexpr int CW_BAR = 4096;
constexpr int CW_QUEUE = 16384;

constexpr int RING_BYTES = 131072;
constexpr int TBL_OFF = RING_BYTES;
constexpr int MISC_OFF = TBL_OFF + 4096;
constexpr int LDS_BYTES = MISC_OFF + 256;
constexpr int A_KOFF = 0, A_KMAX = 24 * 1040;
constexpr int A_VOFF = 2 * 25088, A_VMAX = 16384;
constexpr int A_WSOFF = A_VOFF + 2 * A_VMAX;
constexpr int A_BOFF = A_WSOFF + 2048;
constexpr int A_QROFF = A_BOFF + 2048;
static_assert(A_KMAX <= 25088 && A_QROFF + 8 * 4096 <= RING_BYTES, "attention LDS map");

__device__ __forceinline__ unsigned cvt_pk_bf16(float lo, float hi) { unsigned r; asm volatile("v_cvt_pk_bf16_f32 %0, %1, %2" : "=v"(r) : "v"(lo), "v"(hi)); return r; }
typedef _Float16 f16x2 __attribute__((ext_vector_type(2)));
typedef _Float16 f16x8 __attribute__((ext_vector_type(8)));
__device__ __forceinline__ unsigned cvt_pk_f16(float lo, float hi) { const f16x2 v = {(_Float16)lo, (_Float16)hi}; return __builtin_bit_cast(unsigned, v); }
__device__ __forceinline__ float h_lo(unsigned w) { return (float)__builtin_bit_cast(f16x2, w)[0]; }
__device__ __forceinline__ float h_hi(unsigned w) { return (float)__builtin_bit_cast(f16x2, w)[1]; }
__device__ __forceinline__ float bf_lo(unsigned w) { return __uint_as_float(w << 16); }
__device__ __forceinline__ float bf_hi(unsigned w) { return __uint_as_float(w & 0xffff0000u); }
__device__ __forceinline__ float bf2f(short s) { return __uint_as_float(((unsigned)(unsigned short)s) << 16); }
#define LDS_WAIT() asm volatile("s_waitcnt lgkmcnt(0)" ::: "memory")
#define VM_WAIT() asm volatile("s_waitcnt vmcnt(0)" ::: "memory")
#define SBAR() __builtin_amdgcn_sched_barrier(0)
__device__ __forceinline__ int opaque_tid() { int t = threadIdx.x; asm volatile("" : "+v"(t)); return t; }
__device__ __forceinline__ float part32(float v) { const unsigned u = __float_as_uint(v); auto rr = __builtin_amdgcn_permlane32_swap(u, u, false, false); return __uint_as_float(rr[0] ^ rr[1] ^ u); }
__device__ __forceinline__ float part16(float v) { const unsigned u = __float_as_uint(v); auto rr = __builtin_amdgcn_permlane16_swap(u, u, false, false); return __uint_as_float(rr[0] ^ rr[1] ^ u); }
__device__ __forceinline__ float shx(float v, int mask, int lane) { return __int_as_float(__builtin_amdgcn_ds_bpermute((lane ^ mask) << 2, __float_as_int(v))); }
__device__ __forceinline__ float wave_sum(float v, int lane) {
    v += shx(v, 1, lane); v += shx(v, 2, lane); v += shx(v, 4, lane); v += shx(v, 8, lane); v += part16(v); v += part32(v);
    return v;
}

namespace pg8 {
constexpr int BM = 256, BK = 64, HALF = 128, HTB = HALF * BK * 2, NXCD = 8, WGM = 8;
__host__ __device__ __forceinline__ int lds_byte(int r, int c) { const int st = (r >> 4) * 2 + (c >> 5), rr = r & 15, cc = c & 31, ob = rr * 64 + cc * 2; return st * 1024 + (ob ^ (((ob >> 9) & 1) << 5)); }
__host__ __device__ __forceinline__ void stage_rc(int b, int& R, int& C) { const int st = b / 1024, sb = b % 1024, swz = sb ^ (((sb >> 9) & 1) << 5); R = (st >> 1) * 16 + swz / 64; C = (st & 1) * 32 + (swz % 64) / 2; }
__host__ __device__ __forceinline__ int perm32(int rho) { const int n = rho >> 4, i = rho & 15; return 8 * (i >> 2) + 4 * n + (i & 3); }

struct Unit { int pm, pn; };
struct Gemm { const bf16_t* A; const bf16_t* Bt; };

struct StaticOrder {
    int nM, nN, nwg, G, c, wgm;
    __device__ __forceinline__ void init(int nM_, int nN_, int G_, int c_, int wgm_ = WGM) { nM = nM_; nN = nN_; nwg = nM * nN; G = G_; c = c_; wgm = wgm_; }
    __device__ __forceinline__ bool next(int i, Unit& u) const {
        const long L = (long)i * G + c; if (L >= nwg) return false;
        int wgid = (int)L; { const int q = nwg / NXCD, r = nwg % NXCD, xcd = wgid % NXCD, off = wgid / NXCD; wgid = (xcd < r ? xcd * (q + 1) : r * (q + 1) + (xcd - r) * q) + off; }
        const int nig = wgm * nN, gid = wgid / nig, fm = gid * wgm, gsz = (nM - fm) < wgm ? (nM - fm) : wgm;
        u.pm = fm + ((wgid % nig) % gsz); u.pn = (wgid % nig) / gsz; return true;
    }
};

template <int LDA, int K, class Epi, bool F16 = false, bool TRB1 = false>
__device__ __forceinline__ void gemm_phase(LAS unsigned char* lds, const Gemm g, const StaticOrder& S, const Epi& E) {
    const int tid = opaque_tid(), wid = __builtin_amdgcn_readfirstlane(tid >> 6), lane = tid & 63, wr = wid >> 2, wc = wid & 3, fr = lane & 15, fq = lane >> 4;
    constexpr int nt = K / BK;
    unsigned voffA[2], voffB[2];
#pragma unroll
    for (int i = 0; i < 2; ++i) { int R, C; stage_rc(tid * 16 + i * 8192, R, C); const int Rb = (R & ~31) + perm32(R & 31);
        voffA[i] = (unsigned)(R * LDA + C) * 2u; voffB[i] = (unsigned)(Rb * K + C) * 2u; }
    constexpr size_t kstep = (size_t)(BK * 2);
    constexpr size_t hstepA = (size_t)HALF * LDA * 2, hstepB = (size_t)HALF * K * 2;
    constexpr size_t tstepA = 2 * hstepA, tstepB = 2 * hstepB;
    const unsigned ldsw = (unsigned)wid * 1024u;
    const int aoff = lds_byte(wr * 64 + fr, fq * 8), boff = lds_byte(wc * 32 + fr, fq * 8);
#define PG8_SA(b, h) (((b) * 2 + (h)) * HTB)
#define PG8_SB(b, h) ((4 + (b) * 2 + (h)) * HTB)
#define PG8_STAGE(bufoff, gbase, voff) do { _Pragma("unroll") for (int _i = 0; _i < 2; ++_i) \
        __builtin_amdgcn_global_load_lds((const unsigned*)((const char*)(gbase) + (voff)[_i]), (LAS unsigned*)(lds + (bufoff) + ldsw + _i * 8192), 16, 0, 0); } while (0)
#define PG8_LDA(dst, b, h) do { _Pragma("unroll") for (int m = 0; m < 4; ++m) _Pragma("unroll") for (int k = 0; k < 2; ++k) dst[m][k] = *(const LAS bf16x8*)(lds + PG8_SA(b, h) + aoff + m * 2048 + k * 1024); } while (0)
#define PG8_LDB(dst, b, h) do { _Pragma("unroll") for (int n = 0; n < 2; ++n) _Pragma("unroll") for (int k = 0; k < 2; ++k) dst[n][k] = *(const LAS bf16x8*)(lds + PG8_SB(b, h) + boff + n * 2048 + k * 1024); } while (0)
#define PG8_MMA(ai, bj, At, Bt) do { __builtin_amdgcn_s_setprio(1); _Pragma("unroll") for (int m = 0; m < 4; ++m) _Pragma("unroll") for (int n = 0; n < 2; ++n) _Pragma("unroll") for (int k = 0; k < 2; ++k) \
        acc[ai][bj][m][n] = F16 ? __builtin_amdgcn_mfma_f32_16x16x32_f16(__builtin_bit_cast(f16x8, Bt[n][k]), __builtin_bit_cast(f16x8, At[m][k]), acc[ai][bj][m][n], 0, 0, 0) \
                          : (TRB1 && (bj) == 1) ? __builtin_amdgcn_mfma_f32_16x16x32_bf16(At[m][k], Bt[n][k], acc[ai][bj][m][n], 0, 0, 0) \
                                : __builtin_amdgcn_mfma_f32_16x16x32_bf16(Bt[n][k], At[m][k], acc[ai][bj][m][n], 0, 0, 0); __builtin_amdgcn_s_setprio(0); } while (0)
#define PG8_WAIT_V(n) asm volatile("s_waitcnt vmcnt(" #n ")" ::: "memory")
#define PG8_WAIT_L(n) asm volatile("s_waitcnt lgkmcnt(" #n ")" ::: "memory")
#define PG8_BAR __builtin_amdgcn_s_barrier()
#define PG8_SCHED __builtin_amdgcn_sched_barrier(0)
    Unit cur, nxt; int ui = 0;
    if (!S.next(0, cur)) return;
    f32x4 acc[2][2][4][2];
#pragma unroll
    for (int a = 0; a < 2; ++a)
#pragma unroll
        for (int b = 0; b < 2; ++b)
#pragma unroll
            for (int m = 0; m < 4; ++m)
#pragma unroll
                for (int n = 0; n < 2; ++n) acc[a][b][m][n] = (f32x4){0.f, 0.f, 0.f, 0.f};
    bf16x8 At[4][2], B0[2][2], B1[2][2];
    const char* cA = (const char*)g.A + (size_t)cur.pm * tstepA; const char* cB = (const char*)g.Bt + (size_t)cur.pn * tstepB;
    E.prep(cur, 0, lds, tid);
    PG8_STAGE(PG8_SB(0, 0), cB, voffB); PG8_STAGE(PG8_SB(0, 1), cB + hstepB, voffB); PG8_STAGE(PG8_SA(0, 0), cA, voffA); PG8_STAGE(PG8_SA(0, 1), cA + hstepA, voffA);
    if (wr == 1) PG8_BAR;
    PG8_WAIT_V(2); PG8_BAR;
    PG8_STAGE(PG8_SB(1, 0), cB + kstep, voffB); PG8_STAGE(PG8_SA(1, 0), cA + kstep, voffA); PG8_STAGE(PG8_SB(1, 1), cB + hstepB + kstep, voffB);
    PG8_WAIT_V(6); PG8_BAR;
    for (;;) {
        const bool has_next = S.next(ui + 1, nxt);
        const char* nA = has_next ? (const char*)g.A + (size_t)nxt.pm * tstepA : cA; const char* nB = has_next ? (const char*)g.Bt + (size_t)nxt.pn * tstepB : cB;
#pragma nounroll
        for (int t = 0; t < nt; t += 2) {
            const bool last = (t == nt - 2);
            const char* a1 = cA + (size_t)(t + 1) * kstep;
            const char* a2 = last ? nA : cA + (size_t)(t + 2) * kstep; const char* b2 = last ? nB : cB + (size_t)(t + 2) * kstep;
            const char* a3 = a2 + kstep; const char* b3 = b2 + kstep;
            if (last && has_next) E.prep(nxt, ui + 1, lds, tid);
            PG8_LDB(B0, 0, 0); PG8_LDB(B1, 0, 1); PG8_SCHED; PG8_LDA(At, 0, 0); PG8_STAGE(PG8_SA(1, 1), a1 + hstepA, voffA);
            PG8_WAIT_V(8); PG8_WAIT_L(0); PG8_BAR; PG8_MMA(0, 0, At, B0); PG8_MMA(0, 1, At, B1); PG8_BAR; PG8_SCHED;
            PG8_LDA(At, 0, 1); PG8_STAGE(PG8_SB(0, 0), b2, voffB); PG8_STAGE(PG8_SB(0, 1), b2 + hstepB, voffB); PG8_STAGE(PG8_SA(0, 0), a2, voffA);
            PG8_WAIT_V(8); PG8_WAIT_L(0); PG8_BAR; PG8_MMA(1, 0, At, B0); PG8_MMA(1, 1, At, B1); PG8_BAR; PG8_SCHED;
            PG8_LDB(B0, 1, 0); PG8_LDB(B1, 1, 1); PG8_SCHED; PG8_LDA(At, 1, 0); PG8_STAGE(PG8_SA(0, 1), a2 + hstepA, voffA);
            PG8_WAIT_V(8); PG8_WAIT_L(0); PG8_BAR; PG8_MMA(0, 0, At, B0); PG8_MMA(0, 1, At, B1); PG8_BAR; PG8_SCHED;
            PG8_LDA(At, 1, 1); PG8_STAGE(PG8_SB(1, 0), b3, voffB); PG8_STAGE(PG8_SB(1, 1), b3 + hstepB, voffB); PG8_STAGE(PG8_SA(1, 0), a3, voffA);
            PG8_WAIT_V(8); PG8_WAIT_L(0); PG8_BAR; PG8_MMA(1, 0, At, B0); PG8_MMA(1, 1, At, B1); PG8_BAR; PG8_SCHED;
        }
        if (wr == 0) PG8_BAR;
        E(acc, cur, ui, wr, wc, fr, fq, lds);
        if (!has_next) break;
#pragma unroll
        for (int a = 0; a < 2; ++a)
#pragma unroll
            for (int b = 0; b < 2; ++b)
#pragma unroll
                for (int m = 0; m < 4; ++m)
#pragma unroll
                    for (int n = 0; n < 2; ++n) acc[a][b][m][n] = (f32x4){0.f, 0.f, 0.f, 0.f};
        cur = nxt; cA = nA; cB = nB; ++ui;
        if (wr == 1) PG8_BAR;
    }
    PG8_WAIT_V(0);
    PG8_BAR;
#undef PG8_SA
#undef PG8_SB
#undef PG8_STAGE
#undef PG8_LDA
#undef PG8_LDB
#undef PG8_MMA
#undef PG8_WAIT_V
#undef PG8_WAIT_L
#undef PG8_BAR
#undef PG8_SCHED
}

typedef f32x4 Acc[2][2][4][2];
struct RowScale {
    const float* slab; int npart; float inv_n;
    __device__ __forceinline__ void fill(LAS unsigned char* lds, int ui, int row0, int tid) const {
        if (tid < 256) {
            const float* p = slab + (size_t)(row0 + tid) * npart; float s = 0.f;
            for (int i = 0; i < npart; i += 4) { const f32x4 v = *(const f32x4*)(p + i); s += (v[0] + v[1]) + (v[2] + v[3]); }
            ((LAS float*)(lds + TBL_OFF))[(ui & 1) * 256 + tid] = 1.0f / sqrtf(s * inv_n + EPS);
        }
    }
    __device__ __forceinline__ float get(LAS unsigned char* lds, int ui, int rl) const { return ((const LAS float*)(lds + TBL_OFF))[(ui & 1) * 256 + rl]; }
};
__device__ __forceinline__ float quad_row_sum(float s) { s += part16(s); s += part32(s); return s; }
__device__ __forceinline__ float sq8(const f32x4& a, const f32x4& b) { return (a[0] * a[0] + a[1] * a[1]) + (a[2] * a[2] + a[3] * a[3]) + (b[0] * b[0] + b[1] * b[1]) + (b[2] * b[2] + b[3] * b[3]); }
__device__ __forceinline__ u32x4 pack8(const f32x4& a, const f32x4& b) { u32x4 w; w.x = cvt_pk_bf16(a[0], a[1]); w.y = cvt_pk_bf16(a[2], a[3]); w.z = cvt_pk_bf16(b[0], b[1]); w.w = cvt_pk_bf16(b[2], b[3]); return w; }

template <bool SCALE, bool STATS> struct EpiBf16 {
    bf16_t* O; int ldc; RowScale rs; float* sq; float* skv; int st0; float mul;
    __device__ __forceinline__ void prep(const Unit& u, int ui, LAS unsigned char* lds, int tid) const { if (SCALE) rs.fill(lds, ui, u.pm * BM, tid); }
    __device__ __forceinline__ void operator()(const Acc& acc, const Unit& u, int ui, int wr, int wc, int fr, int fq, LAS unsigned char* lds) const {
        const int col0 = u.pn * BM + wc * 32 + 8 * fq;
        const int st = STATS ? (u.pn - st0) : -1;
#pragma unroll
        for (int ai = 0; ai < 2; ++ai)
#pragma unroll
            for (int m = 0; m < 4; ++m) {
                const int rl = ai * HALF + wr * 64 + m * 16 + fr; const size_t row = (size_t)u.pm * BM + rl;
                const float s = SCALE ? rs.get(lds, ui, rl) * mul : 1.f;
                bf16_t* rowp = O + row * ldc + col0; float ss = 0.f;
#pragma unroll
                for (int bj = 0; bj < 2; ++bj) { const f32x4 v0 = acc[ai][bj][m][0] * s, v1 = acc[ai][bj][m][1] * s;
                    if (STATS) ss += sq8(v0, v1);
                    *(u32x4*)(rowp + bj * HALF) = pack8(v0, v1); }
                if (STATS) { if (st >= 0 && st < 3) { ss = quad_row_sum(ss); if (fq == 0) { if (st < 2) sq[row * 8 + st * 4 + wc] = ss; else skv[row * 4 + wc] = ss; } } }
            }
    }
};
__device__ __forceinline__ u32x4 pack8h(const f32x4& a, const f32x4& b) { u32x4 w; w.x = cvt_pk_f16(a[0], a[1]); w.y = cvt_pk_f16(a[2], a[3]); w.z = cvt_pk_f16(b[0], b[1]); w.w = cvt_pk_f16(b[2], b[3]); return w; }
struct EpiRes1 {
    bf16_t* xb; float* slab;
    __device__ __forceinline__ void prep(const Unit&, int, LAS unsigned char*, int) const {}
    __device__ __forceinline__ void operator()(const Acc& acc, const Unit& u, int ui, int wr, int wc, int fr, int fq, LAS unsigned char* lds) const {
        int fre = fr, fqe = fq; asm volatile("" : "+v"(fre), "+v"(fqe));
        bf16_t* xt = xb + (size_t)u.pm * BM * DM + u.pn * BM + wc * 32 + (unsigned)((wr * 64 + fre) * DM + 8 * fqe);
        float sa[2][4];
#pragma unroll
        for (int ai = 0; ai < 2; ++ai) {
            u32x4 pre[4][2];
#pragma unroll
            for (int m = 0; m < 4; ++m)
#pragma unroll
                for (int bj = 0; bj < 2; ++bj) pre[m][bj] = *(const u32x4*)(xt + (ai * HALF + m * 16) * DM + bj * HALF);
#pragma unroll
            for (int m = 0; m < 4; ++m) {
                float ss = 0.f;
#pragma unroll
                for (int bj = 0; bj < 2; ++bj) { const u32x4 pw = pre[m][bj];
                    const f32x4 v0 = acc[ai][bj][m][0] + (f32x4){h_lo(pw.x), h_hi(pw.x), h_lo(pw.y), h_hi(pw.y)}, v1 = acc[ai][bj][m][1] + (f32x4){h_lo(pw.z), h_hi(pw.z), h_lo(pw.w), h_hi(pw.w)};
                    ss += sq8(v0, v1);
                    *(u32x4*)(xt + (ai * HALF + m * 16) * DM + bj * HALF) = pack8h(v0, v1); }
                sa[ai][m] = quad_row_sum(ss);
            }
        }
#pragma unroll
        for (int ai = 0; ai < 2; ++ai) { const float v = fqe == 0 ? sa[ai][0] : fqe == 1 ? sa[ai][1] : fqe == 2 ? sa[ai][2] : sa[ai][3];
            slab[((size_t)u.pm * BM + ai * HALF + wr * 64 + fqe * 16 + fre) * 32 + u.pn * 4 + wc] = v; }
    }
};
struct EpiGate {
    const bf16_t* xb; const bf16_t* pe; bf16_t* xbn; float* slab; RowScale rs;
    __device__ __forceinline__ void prep(const Unit& u, int ui, LAS unsigned char* lds, int tid) const { rs.fill(lds, ui, u.pm * BM, tid); }
    __device__ __forceinline__ void operator()(const Acc& acc, const Unit& u, int ui, int wr, int wc, int fr, int fq, LAS unsigned char* lds) const {
        int fre = fr, fqe = fq; asm volatile("" : "+v"(fre), "+v"(fqe));
        const size_t t0 = (size_t)u.pm * BM * DM + u.pn * BM + wc * 32 + (unsigned)((wr * 64 + fre) * DM + 8 * fqe);
        float sa[2][4];
#pragma unroll
        for (int ai = 0; ai < 2; ++ai)
#pragma unroll
            for (int mp = 0; mp < 2; ++mp) {
                u32x4 px[2][2], pp[2][2];
#pragma unroll
                for (int mm = 0; mm < 2; ++mm)
#pragma unroll
                    for (int bj = 0; bj < 2; ++bj) { const size_t o_ = t0 + (ai * HALF + (mp * 2 + mm) * 16) * DM + bj * HALF;
                        px[mm][bj] = *(const u32x4*)(xb + o_); pp[mm][bj] = *(const u32x4*)(pe + o_); }
#pragma unroll
                for (int mm = 0; mm < 2; ++mm) {
                    const int m = mp * 2 + mm;
                    const int rl = ai * HALF + wr * 64 + m * 16 + fre;
                    const float s = rs.get(lds, ui, rl) * -1.4426950408889634f; float ss = 0.f;
#pragma unroll
                    for (int bj = 0; bj < 2; ++bj) { const u32x4 xw = px[mm][bj], pw = pp[mm][bj];
                        const f32x4 x0 = {h_lo(xw.x), h_hi(xw.x), h_lo(xw.y), h_hi(xw.y)}, x1 = {h_lo(xw.z), h_hi(xw.z), h_lo(xw.w), h_hi(xw.w)};
                        const f32x4 p0 = {bf_lo(pw.x), bf_hi(pw.x), bf_lo(pw.y), bf_hi(pw.y)}, p1 = {bf_lo(pw.z), bf_hi(pw.z), bf_lo(pw.w), bf_hi(pw.w)};
                        f32x4 v0, v1;
#pragma unroll
                        for (int e = 0; e < 4; ++e) { const float g0_ = __builtin_amdgcn_rcpf(1.f + __builtin_amdgcn_exp2f(acc[ai][bj][m][0][e] * s)), g1_ = __builtin_amdgcn_rcpf(1.f + __builtin_amdgcn_exp2f(acc[ai][bj][m][1][e] * s));
                            v0[e] = x0[e] + p0[e] * g0_; v1[e] = x1[e] + p1[e] * g1_; }
                        ss += sq8(v0, v1);
                        *(u32x4*)(xbn + t0 + (ai * HALF + m * 16) * DM + bj * HALF) = pack8h(v0, v1); }
                    sa[ai][m] = quad_row_sum(ss);
                }
            }
#pragma unroll
        for (int ai = 0; ai < 2; ++ai) { const float v = fqe == 0 ? sa[ai][0] : fqe == 1 ? sa[ai][1] : fqe == 2 ? sa[ai][2] : sa[ai][3];
            slab[((size_t)u.pm * BM + ai * HALF + wr * 64 + fqe * 16 + fre) * 32 + u.pn * 4 + wc] = v; }
    }
};
struct EpiKV8 {
    unsigned char* kn8; unsigned char* v8; RowScale rs;
    __device__ __forceinline__ void prep(const Unit& u, int ui, LAS unsigned char* lds, int tid) const { rs.fill(lds, ui, u.pm * BM, tid); }
    __device__ __forceinline__ void operator()(const Acc& acc, const Unit& u, int ui, int wr, int wc, int fr, int fq, LAS unsigned char* lds) const {
        int fre = fr, fqe = fq; asm volatile("" : "+v"(fre), "+v"(fqe));
        const LAS float* tbl = (const LAS float*)(lds + TBL_OFF) + (ui & 1) * 256;
#pragma unroll
        for (int ai = 0; ai < 2; ++ai) {
            const size_t blk = ((size_t)(u.pm * 4 + ai * 2 + wr) * 6 + u.pn) * 8192;
            unsigned kw[4][2], vw[4][2];
#pragma unroll
            for (int m = 0; m < 4; ++m) {
                { const float s = tbl[ai * HALF + wr * 64 + m * 16 + fre];
                  const f32x4 v0 = acc[ai][0][m][0] * s, v1 = acc[ai][0][m][1] * s;
                  int w0 = 0, w1 = 0;
                  w0 = __builtin_amdgcn_cvt_pk_fp8_f32(v0[0], v0[1], w0, false); w0 = __builtin_amdgcn_cvt_pk_fp8_f32(v0[2], v0[3], w0, true);
                  w1 = __builtin_amdgcn_cvt_pk_fp8_f32(v1[0], v1[1], w1, false); w1 = __builtin_amdgcn_cvt_pk_fp8_f32(v1[2], v1[3], w1, true);
                  kw[m][0] = (unsigned)w0; kw[m][1] = (unsigned)w1; }
                { const f32x4 s4 = *(const LAS f32x4*)(tbl + ai * HALF + wr * 64 + m * 16 + 4 * fqe);
#pragma unroll
                  for (int n = 0; n < 2; ++n) { const f32x4 v = acc[ai][1][m][n] * s4; int w = 0;
                      w = __builtin_amdgcn_cvt_pk_fp8_f32(v[0], v[1], w, false); w = __builtin_amdgcn_cvt_pk_fp8_f32(v[2], v[3], w, true); vw[m][n] = (unsigned)w; } }
            }
#pragma unroll
            for (int mp = 0; mp < 2; ++mp) {
                const auto r0 = __builtin_amdgcn_permlane16_swap(kw[2 * mp][0], kw[2 * mp + 1][0], false, false);
                const auto r1 = __builtin_amdgcn_permlane16_swap(kw[2 * mp][1], kw[2 * mp + 1][1], false, false);
                const int key = (2 * mp + (fqe & 1)) * 16 + fre;
                *(u32x4*)(kn8 + blk + (wc * 2 + (fqe >> 1)) * 1024 + key * 16) = (u32x4){r0[0], r1[0], r0[1], r1[1]};
            }
#pragma unroll
            for (int n = 0; n < 2; ++n) {
                const auto e0 = __builtin_amdgcn_permlane32_swap(vw[0][n], vw[2][n], false, false);
                const auto e1 = __builtin_amdgcn_permlane32_swap(vw[1][n], vw[3][n], false, false);
                const int col = wc * 32 + 8 * (fre >> 2) + 4 * n + (fre & 3), g = 2 * (fqe & 1) + (fqe >> 1);
                *(u32x4*)(v8 + blk + col * 64 + ((g ^ ((col >> 2) & 3)) << 4)) = (u32x4){e0[0], e0[1], e1[0], e1[1]};
            }
        }
    }
};
}

namespace att {
constexpr float LOG2E = 1.4426950408889634f;
constexpr float THR = 6.f;
__device__ __forceinline__ int crow(int r, int hi) { return (r & 3) + 8 * (r >> 2) + 4 * hi; }
template <int KIND> struct Cfg;
template <> struct Cfg<0> { static constexpr int NDQ = 12, NDV = 4, H = 6; static constexpr float SCALE = 0.07216878364870323f; };
template <> struct Cfg<1> { static constexpr int NDQ = 4, NDV = 2, H = 12; static constexpr float SCALE = 0.125f; };
template <> struct Cfg<2> { static constexpr int NDQ = 4, NDV = 2, H = 8; static constexpr float SCALE = 0.125f; };

struct Ctx {
    bf16_t* proj; const bf16_t* q; const bf16_t* kv; const unsigned char* kf8; const unsigned char* gv8; const unsigned char* kn8; const unsigned char* v8; const unsigned char* kr8;
    const f32x2* ropeT; const f32x2* rowT; const f32x2* colT;
    const float* gq_norm; const float* gk_norm; const float* rpb;
};

template <int NDV> __device__ __forceinline__ int v_st(int k, int c) { const int kk = (k & ~0xC) | ((k & 4) << 1) | ((k & 8) >> 1); return ((kk >> 3) * NDV + (c >> 5)) * 512 + ((kk & 7) * 32 + (c & 31)) * 2; }
__device__ __forceinline__ int v_rd_base(int lane) { return ((lane & 3) << 3) | (((lane >> 2) & 3) << 6) | (((lane >> 4) & 1) << 5) | (((lane >> 5) & 1) << 8); }
template <int OFF> __device__ __forceinline__ s16x4 tr_read(unsigned vb) { s16x4 r; asm volatile("ds_read_b64_tr_b16 %0, %1 offset:%2" : "=&v"(r) : "v"(vb), "i"(OFF) : "memory"); return r; }

template <int C1000> struct Dummy {};
template <int KIND> __device__ __forceinline__ void softmax_tile(f32x16& p0, f32x16& p1, float& m_reg, float& l_reg, float& alpha, bf16x8& pa0, bf16x8& pa1, bf16x8& pa2, bf16x8& pa3) {
    constexpr float SC = Cfg<KIND>::SCALE, C = SC * LOG2E;
    float pmax = p0[0];
#pragma unroll
    for (int r = 1; r < 16; ++r) pmax = fmaxf(pmax, p0[r]);
#pragma unroll
    for (int r = 0; r < 16; ++r) pmax = fmaxf(pmax, p1[r]);
    { auto rr = __builtin_amdgcn_permlane32_swap(__float_as_uint(pmax), __float_as_uint(pmax), false, false);
      pmax = fmaxf(__uint_as_float(rr[0]), __uint_as_float(rr[1])); }
    float mn;
    if (__builtin_expect(__all(pmax - m_reg <= THR / SC), 1)) { mn = m_reg; alpha = 1.f; }
    else { mn = fmaxf(m_reg, pmax); alpha = __builtin_amdgcn_exp2f((m_reg - mn) * C); m_reg = mn; }
    const float mnC = -mn * C;
#pragma unroll
    for (int r = 0; r < 16; ++r) { p0[r] = __builtin_amdgcn_exp2f(fmaf(p0[r], C, mnC)); p1[r] = __builtin_amdgcn_exp2f(fmaf(p1[r], C, mnC)); }
    float ps = 0.f;
#pragma unroll
    for (int r = 0; r < 16; ++r) ps += p0[r];
#pragma unroll
    for (int r = 0; r < 16; ++r) ps += p1[r];
    { auto rr = __builtin_amdgcn_permlane32_swap(__float_as_uint(ps), __float_as_uint(ps), false, false);
      ps = __uint_as_float(rr[0]) + __uint_as_float(rr[1]); }
    l_reg = l_reg * alpha + ps;
#define PK4(P, BASE, OUT) do { unsigned a0 = cvt_pk_bf16(P[BASE + 0], P[BASE + 1]), a1 = cvt_pk_bf16(P[BASE + 2], P[BASE + 3]);   \
    unsigned b0 = cvt_pk_bf16(P[BASE + 4], P[BASE + 5]), b1 = cvt_pk_bf16(P[BASE + 6], P[BASE + 7]);                              \
    auto r0 = __builtin_amdgcn_permlane32_swap(a0, b0, false, false); auto r1 = __builtin_amdgcn_permlane32_swap(a1, b1, false, false); \
    u32x4 w = {r0[0], r1[0], r0[1], r1[1]}; OUT = __builtin_bit_cast(bf16x8, w); } while (0)
    PK4(p0, 0, pa0); PK4(p0, 8, pa1); PK4(p1, 0, pa2); PK4(p1, 8, pa3);
#undef PK4
}
constexpr float THR2 = 8.f;
__device__ __forceinline__ void softmax_ref(f32x16& p0, f32x16& p1, float& mhat, float& l_reg, float& alpha, bool first, bf16x8& pa0, bf16x8& pa1, bf16x8& pa2, bf16x8& pa3) {
    float a_ = fmaxf(fmaxf(p0[0], p0[1]), p1[0]), b_ = fmaxf(fmaxf(p0[2], p0[3]), p1[1]); a_ = fmaxf(fmaxf(a_, p1[2]), p1[3]);
#pragma unroll
    for (int r = 4; r < 16; r += 4) { a_ = fmaxf(fmaxf(a_, p0[r]), p0[r + 1]); b_ = fmaxf(fmaxf(b_, p0[r + 2]), p0[r + 3]); a_ = fmaxf(fmaxf(a_, p1[r]), p1[r + 1]); b_ = fmaxf(fmaxf(b_, p1[r + 2]), p1[r + 3]); }
    float rm = fmaxf(a_, b_);
    { auto rr = __builtin_amdgcn_permlane32_swap(__float_as_uint(rm), __float_as_uint(rm), false, false); rm = fmaxf(__uint_as_float(rr[0]), __uint_as_float(rr[1])); }
    alpha = 1.f;
    const bool ok = first ? (fabsf(rm) <= THR2) : (rm - mhat <= THR2);
    if (__builtin_expect(!__all(ok), 0)) { const float mn = first ? rm : fmaxf(mhat, rm); alpha = first ? 1.f : __builtin_amdgcn_exp2f(mhat - mn); mhat = mn; }
    if (__builtin_expect(__any(mhat != 0.f), 0)) {
#pragma unroll
        for (int r = 0; r < 16; ++r) { p0[r] -= mhat; p1[r] -= mhat; } }
#pragma unroll
    for (int r = 0; r < 16; ++r) { p0[r] = __builtin_amdgcn_exp2f(p0[r]); p1[r] = __builtin_amdgcn_exp2f(p1[r]); }
    float ps0 = 0.f, ps1 = 0.f;
#pragma unroll
    for (int r = 0; r < 16; ++r) { ps0 += p0[r]; ps1 += p1[r]; }
    float ps = ps0 + ps1;
    { auto rr = __builtin_amdgcn_permlane32_swap(__float_as_uint(ps), __float_as_uint(ps), false, false); ps = __uint_as_float(rr[0]) + __uint_as_float(rr[1]); }
    l_reg = l_reg * alpha + ps;
#define PK4(P, BASE, OUT) do { unsigned a0 = cvt_pk_bf16(P[BASE + 0], P[BASE + 1]), a1 = cvt_pk_bf16(P[BASE + 2], P[BASE + 3]);   \
    unsigned b0 = cvt_pk_bf16(P[BASE + 4], P[BASE + 5]), b1 = cvt_pk_bf16(P[BASE + 6], P[BASE + 7]);                              \
    auto r0 = __builtin_amdgcn_permlane32_swap(a0, b0, false, false); auto r1 = __builtin_amdgcn_permlane32_swap(a1, b1, false, false); \
    u32x4 w = {r0[0], r1[0], r0[1], r1[1]}; OUT = __builtin_bit_cast(bf16x8, w); } while (0)
    PK4(p0, 0, pa0); PK4(p0, 8, pa1); PK4(p1, 0, pa2); PK4(p1, 8, pa3);
#undef PK4
}
template <int NDQ> __device__ __forceinline__ void qkt(f32x16& p0, f32x16& p1, const LAS unsigned char* Kb, const bf16x8* qr, int r32, int hi) {
    p0 = f32x16{}; p1 = f32x16{};
    const LAS unsigned char* kp = Kb + hi * 1040 + r32 * 16;
    constexpr int PF = 2;
    bf16x8 kb0[PF], kb1[PF];
#pragma unroll
    for (int d0 = 0; d0 < PF; ++d0) { kb0[d0] = *(const LAS bf16x8*)(kp + d0 * 2080); kb1[d0] = *(const LAS bf16x8*)(kp + d0 * 2080 + 512); }
    SBAR();
#pragma unroll
    for (int d0 = 0; d0 < NDQ; ++d0) {
        p0 = __builtin_amdgcn_mfma_f32_32x32x16_bf16(kb0[d0 % PF], qr[d0], p0, 0, 0, 0);
        p1 = __builtin_amdgcn_mfma_f32_32x32x16_bf16(kb1[d0 % PF], qr[d0], p1, 0, 0, 0);
        if (d0 + PF < NDQ) { kb0[d0 % PF] = *(const LAS bf16x8*)(kp + (d0 + PF) * 2080); kb1[d0 % PF] = *(const LAS bf16x8*)(kp + (d0 + PF) * 2080 + 512); }
        SBAR();
    }
}
__device__ __forceinline__ void qkt_mla(f32x16& p0, f32x16& p1, const LAS unsigned char* Kb, const bf16x8* qr, const LAS unsigned char* qrope, int r32, int hi) {
    p0 = f32x16{}; p1 = f32x16{};
    const LAS unsigned char* kp = Kb + hi * 1040 + r32 * 16;
    constexpr int PF = 2;
    bf16x8 kb0[PF], kb1[PF], qx[4];
#pragma unroll
    for (int d0 = 0; d0 < PF; ++d0) { kb0[d0] = *(const LAS bf16x8*)(kp + d0 * 2080); kb1[d0] = *(const LAS bf16x8*)(kp + d0 * 2080 + 512); }
#pragma unroll
    for (int d0 = 0; d0 < 4; ++d0) qx[d0] = *(const LAS bf16x8*)(qrope + d0 * 1024);
    SBAR();
#pragma unroll
    for (int d0 = 0; d0 < 12; ++d0) {
        const bf16x8 q = (d0 < 8) ? qr[d0 < 8 ? d0 : 0] : qx[d0 >= 8 ? d0 - 8 : 0];
        p0 = __builtin_amdgcn_mfma_f32_32x32x16_bf16(kb0[d0 % PF], q, p0, 0, 0, 0);
        p1 = __builtin_amdgcn_mfma_f32_32x32x16_bf16(kb1[d0 % PF], q, p1, 0, 0, 0);
        if (d0 + PF < 12) { kb0[d0 % PF] = *(const LAS bf16x8*)(kp + (d0 + PF) * 2080); kb1[d0 % PF] = *(const LAS bf16x8*)(kp + (d0 + PF) * 2080 + 512); }
        SBAR();
    }
}
template <int NDV, int D0> __device__ __forceinline__ void pv_one(f32x16& od, unsigned vb, bf16x8 pa0, bf16x8 pa1, bf16x8 pa2, bf16x8 pa3) {
    constexpr int KS = NDV * 1024, HF = NDV * 512;
    const s16x4 l0 = tr_read<D0 * 512 + 0 * KS>(vb), h0 = tr_read<D0 * 512 + 0 * KS + HF>(vb), l1 = tr_read<D0 * 512 + 1 * KS>(vb), h1 = tr_read<D0 * 512 + 1 * KS + HF>(vb);
    const s16x4 l2 = tr_read<D0 * 512 + 2 * KS>(vb), h2 = tr_read<D0 * 512 + 2 * KS + HF>(vb), l3 = tr_read<D0 * 512 + 3 * KS>(vb), h3 = tr_read<D0 * 512 + 3 * KS + HF>(vb);
    asm volatile("s_waitcnt lgkmcnt(0)" ::: "memory"); SBAR();
#define PK(L, H) (bf16x8){L[0], L[1], L[2], L[3], H[0], H[1], H[2], H[3]}
    od = __builtin_amdgcn_mfma_f32_32x32x16_bf16(pa0, PK(l0, h0), od, 0, 0, 0);
    od = __builtin_amdgcn_mfma_f32_32x32x16_bf16(pa1, PK(l1, h1), od, 0, 0, 0);
    od = __builtin_amdgcn_mfma_f32_32x32x16_bf16(pa2, PK(l2, h2), od, 0, 0, 0);
    od = __builtin_amdgcn_mfma_f32_32x32x16_bf16(pa3, PK(l3, h3), od, 0, 0, 0);
#undef PK
}


typedef short v4i16_t __attribute__((ext_vector_type(4)));
__device__ __forceinline__ s16x4 vtr(const LAS unsigned char* p) { return __builtin_bit_cast(s16x4, __builtin_amdgcn_ds_read_tr16_b64_v4i16((LAS v4i16_t*)p)); }
struct VF { s16x4 l0, h0, l1, h1, l2, h2, l3, h3; };
template <int NDV, int D0> __device__ __forceinline__ void v_read(VF& f, const LAS unsigned char* vp) {
    constexpr int KS = NDV * 1024, HF = NDV * 512, B = D0 * 512;
    f.l0 = vtr(vp + B); f.h0 = vtr(vp + B + HF); f.l1 = vtr(vp + B + KS); f.h1 = vtr(vp + B + KS + HF);
    f.l2 = vtr(vp + B + 2 * KS); f.h2 = vtr(vp + B + 2 * KS + HF); f.l3 = vtr(vp + B + 3 * KS); f.h3 = vtr(vp + B + 3 * KS + HF);
}
__device__ __forceinline__ void pv_mma(f32x16& od, const VF& f, bf16x8 pa0, bf16x8 pa1, bf16x8 pa2, bf16x8 pa3) {
#define PK(L, H) (bf16x8){L[0], L[1], L[2], L[3], H[0], H[1], H[2], H[3]}
    od = __builtin_amdgcn_mfma_f32_32x32x16_bf16(pa0, PK(f.l0, f.h0), od, 0, 0, 0);
    od = __builtin_amdgcn_mfma_f32_32x32x16_bf16(pa1, PK(f.l1, f.h1), od, 0, 0, 0);
    od = __builtin_amdgcn_mfma_f32_32x32x16_bf16(pa2, PK(f.l2, f.h2), od, 0, 0, 0);
    od = __builtin_amdgcn_mfma_f32_32x32x16_bf16(pa3, PK(f.l3, f.h3), od, 0, 0, 0);
#undef PK
}

constexpr int EPI_PITCH = 36, EPI_WAVE_BYTES = 32 * EPI_PITCH * 4;
template <class RowOff>
__device__ __forceinline__ void epi_gates(u32x4 (&gw)[2], int lane, const bf16_t* gate0, RowOff rowoff) {
#pragma unroll
    for (int p = 0; p < 2; ++p) { const int t = lane + 64 * p, row = t >> 2, cg = t & 3; gw[p] = *(const u32x4*)(gate0 + rowoff(row) + cg * 8); }
}
template <class RowOff>
__device__ __forceinline__ void epi_block(LAS float* S, const f32x16& od, const LAS float* ltab, int lane, const u32x4 (&gwp)[2], bf16_t* out0, RowOff rowoff, const bool DRY) {
    const int r32 = lane & 31, hi = lane >> 5;
#pragma unroll
    for (int r = 0; r < 16; ++r) { const int orow = crow(r, hi); S[orow * EPI_PITCH + r32] = od[r] * __builtin_amdgcn_rcpf(ltab[orow]); }
    asm volatile("s_waitcnt lgkmcnt(0)" ::: "memory");
#pragma unroll
    for (int p = 0; p < 2; ++p) {
        const int t = lane + 64 * p, row = t >> 2, cg = t & 3;
        const f32x4 a = *(const LAS f32x4*)(S + row * EPI_PITCH + cg * 8), b = *(const LAS f32x4*)(S + row * EPI_PITCH + cg * 8 + 4);
        const size_t ro = rowoff(row) + cg * 8;
        const u32x4 gw = gwp[p];
        const float gt[8] = {bf_lo(gw.x), bf_hi(gw.x), bf_lo(gw.y), bf_hi(gw.y), bf_lo(gw.z), bf_hi(gw.z), bf_lo(gw.w), bf_hi(gw.w)};
        float y[8];
#pragma unroll
        for (int i = 0; i < 8; ++i) y[i] = (i < 4 ? a[i] : b[i - 4]) * gt[i] * __builtin_amdgcn_rcpf(1.f + __builtin_amdgcn_exp2f(-gt[i] * LOG2E));
        if (!DRY) *(u32x4*)(out0 + ro) = (u32x4){cvt_pk_bf16(y[0], y[1]), cvt_pk_bf16(y[2], y[3]), cvt_pk_bf16(y[4], y[5]), cvt_pk_bf16(y[6], y[7])};
    }
    asm volatile("s_waitcnt lgkmcnt(0)" ::: "memory");
}

__device__ __forceinline__ void na_unit(const Ctx& c, int s0, int slen, int h, int qb, LAS unsigned char* lds, const bool DRY) {
    constexpr int KB = 8320, VB = 8192;
    const int tid = opaque_tid(), lane = tid & 63, r32 = lane & 31, hi = lane >> 5;
    const int wid = __builtin_amdgcn_readfirstlane(tid >> 6);
    const int rows = slen >> 6, r0 = qb * 4;
    const int lo = min(max(r0 - 4, 0), rows - 8), hi_r = min(max(r0 + 3 - 4, 0), rows - 8) + 7;
    const int NT = hi_r - lo + 1;
    const int rA = r0 + 2 * (wid >> 2);
    const int c0 = 16 * (wid & 3), kc0 = min(max(c0 - 8, 0), 32);
    const int wlo = min(max(rA - 4, 0), rows - 8), whi = min(max(rA + 1 - 4, 0), rows - 8) + 8;
    const int qrow = rA + (r32 >> 4), qcol = c0 + (r32 & 15);
    const int rsq = min(max(qrow - 4, 0), rows - 8), csq = min(max(qcol - 8, 0), 48);
    const int tq = qrow * 64 + qcol;
    const size_t Rq = (size_t)(s0 + tq);
    bf16x8 qr[4];
    { const bf16_t* qp = c.proj + Rq * LDP + C_NAQ + h * 64 + hi * 8;
#pragma unroll
      for (int d0 = 0; d0 < 4; ++d0) qr[d0] = *(const bf16x8*)(qp + d0 * 16); }
    unsigned cmask = 0u;
#pragma unroll
    for (int r = 0; r < 16; ++r) { const int kc = kc0 + crow(r, hi); cmask |= ((kc >= csq) && (kc < csq + 16)) ? (1u << r) : 0u; }
    constexpr int NA_KOFF = 0, NA_VOFF = 50176, NA_WSOFF = NA_VOFF + 6 * 8192, NA_BOFF2 = NA_WSOFF + 2048;
    static_assert(6 * 8320 <= NA_VOFF && NA_BOFF2 + 2048 <= RING_BYTES, "NA LDS map");
    LAS unsigned char* Kn = lds + NA_KOFF; LAS unsigned char* Vn = lds + NA_VOFF;
    const int kr_ = tid >> 3, cr_ = tid & 7;
    const bf16_t* gk0 = c.proj + ((size_t)s0 + (size_t)lo * 64 + kr_) * LDP + C_NAK + h * 64 + cr_ * 8;
    constexpr size_t tstride = (size_t)64 * LDP;
    const int lk0 = cr_ * 1040 + kr_ * 16, lv0 = v_st<2>(kr_, cr_ * 8);
    bf16x8 sk[6], sv[6];
#define NA_LOAD(t0, n) do { _Pragma("unroll") for (int t = 0; t < 6; ++t) if (t < (n)) { sk[t] = *(const bf16x8*)(gk0 + (size_t)((t0) + t) * tstride); sv[t] = *(const bf16x8*)(gk0 + (size_t)((t0) + t) * tstride + (C_NAV - C_NAK)); } } while (0)
#define NA_WRITE(n) do { _Pragma("unroll") for (int t = 0; t < 6; ++t) if (t < (n)) { *(LAS bf16x8*)(Kn + t * KB + lk0) = sk[t]; *(LAS bf16x8*)(Vn + t * VB + lv0) = sv[t]; } } while (0)
    int va[2][2];
#pragma unroll
    for (int ks = 0; ks < 2; ++ks)
#pragma unroll
        for (int hf = 0; hf < 2; ++hf) { const int k = kc0 + 16 * ks + 8 * hi + 4 * hf; const int kk = (k & ~0xC) | ((k & 4) << 1) | ((k & 8) >> 1);
            va[ks][hf] = ((kk >> 3) * 2) * 512 + (kk & 7) * 64 + (((lane & 3) << 3) | (((lane >> 2) & 3) << 6) | (((lane >> 4) & 1) << 5)); }
    const LAS unsigned char* kp0 = Kn + hi * 1040 + (kc0 + r32) * 16;
    LAS float* wsn = (LAS float*)(lds + NA_WSOFF) + wid * 64;
    LAS float* bn = (LAS float*)(lds + NA_BOFF2);
    for (int i = tid; i < 15 * 32; i += 512) { const int di = i >> 5, dj = i & 31; bn[i] = (dj < 31) ? c.rpb[(h * 15 + di) * 31 + dj] * LOG2E : 0.f; }
    float mhat = 0.f, l_reg = 0.f; bool seen = false; f32x16 o[2];
    o[0] = f32x16{}; o[1] = f32x16{};
    const int nB = NT - 6;
    NA_LOAD(0, 6); NA_WRITE(6); NA_LOAD(6, nB);
    __syncthreads();
    for (int ch = 0; ch < 2; ++ch) {
        const int nt = ch ? nB : 6;
#pragma nounroll
        for (int t = 0; t < nt; ++t) {
            const int kr = lo + ch * 6 + t;
            if (kr >= wlo && kr < whi) {
                f32x16 p = f32x16{};
                const LAS unsigned char* kp = kp0 + t * KB;
#pragma unroll
                for (int d0 = 0; d0 < 4; ++d0) p = __builtin_amdgcn_mfma_f32_32x32x16_bf16(*(const LAS bf16x8*)(kp + d0 * 2080), qr[d0], p, 0, 0, 0);
                const bool rowok = (kr >= rsq) && (kr < rsq + 8);
                const int di = min(max(kr - qrow + 7, 0), 14);
                const LAS float* br = bn + di * 32 + (15 - qcol) + kc0;
#pragma unroll
                for (int r = 0; r < 16; ++r) { const bool v = rowok && ((cmask >> r) & 1u); const float bv = br[v ? crow(r, hi) : (qcol - kc0)]; p[r] = v ? p[r] + bv : -1e30f; }
                float a_ = fmaxf(fmaxf(p[0], p[1]), p[2]), b_ = fmaxf(fmaxf(p[3], p[4]), p[5]);
                a_ = fmaxf(fmaxf(a_, p[6]), p[7]); b_ = fmaxf(fmaxf(b_, p[8]), p[9]); a_ = fmaxf(fmaxf(a_, p[10]), p[11]); b_ = fmaxf(fmaxf(b_, p[12]), p[13]); a_ = fmaxf(fmaxf(a_, p[14]), p[15]);
                float rm = fmaxf(a_, b_); rm = fmaxf(rm, part32(rm));
                const bool has = rm > -1e29f;
                float alpha = 1.f;
                const bool okl = !has || (seen ? (rm - mhat <= THR2) : (fabsf(rm) <= THR2));
                if (__builtin_expect(!__all(okl), 0)) { if (has) { const float mn = seen ? fmaxf(mhat, rm) : rm; alpha = seen ? __builtin_amdgcn_exp2f(mhat - mn) : 1.f; mhat = mn; } }
                seen = seen || has;
                if (__builtin_expect(__any(mhat != 0.f), 0)) {
#pragma unroll
                    for (int r = 0; r < 16; ++r) p[r] -= mhat; }
#pragma unroll
                for (int r = 0; r < 16; ++r) p[r] = __builtin_amdgcn_exp2f(p[r]);
                float ps = 0.f;
#pragma unroll
                for (int r = 0; r < 16; ++r) ps += p[r];
                ps += part32(ps);
                l_reg = l_reg * alpha + ps;
                bf16x8 paA, paB;
#define PK4(P, BASE, OUT) do { unsigned a0 = cvt_pk_bf16(P[BASE + 0], P[BASE + 1]), a1 = cvt_pk_bf16(P[BASE + 2], P[BASE + 3]);   \
    unsigned b0 = cvt_pk_bf16(P[BASE + 4], P[BASE + 5]), b1 = cvt_pk_bf16(P[BASE + 6], P[BASE + 7]);                              \
    auto r0_ = __builtin_amdgcn_permlane32_swap(a0, b0, false, false); auto r1_ = __builtin_amdgcn_permlane32_swap(a1, b1, false, false); \
    u32x4 w = {r0_[0], r1_[0], r0_[1], r1_[1]}; OUT = __builtin_bit_cast(bf16x8, w); } while (0)
                PK4(p, 0, paA); PK4(p, 8, paB);
#undef PK4
                if (__any(alpha < 1.f)) { if (hi == 0) wsn[r32] = alpha; LDS_WAIT();
#pragma unroll
                    for (int d = 0; d < 2; ++d)
#pragma unroll
                        for (int r = 0; r < 16; ++r) o[d][r] *= wsn[crow(r, hi)];
                    LDS_WAIT(); }
                const LAS unsigned char* vp = Vn + t * VB;
                const s16x4 l0 = vtr(vp + va[0][0]), h0 = vtr(vp + va[0][1]), l1 = vtr(vp + va[1][0]), h1 = vtr(vp + va[1][1]);
                const s16x4 m0 = vtr(vp + va[0][0] + 512), n0 = vtr(vp + va[0][1] + 512), m1 = vtr(vp + va[1][0] + 512), n1 = vtr(vp + va[1][1] + 512);
#define PK(L, H) (bf16x8){L[0], L[1], L[2], L[3], H[0], H[1], H[2], H[3]}
                o[0] = __builtin_amdgcn_mfma_f32_32x32x16_bf16(paA, PK(l0, h0), o[0], 0, 0, 0);
                o[1] = __builtin_amdgcn_mfma_f32_32x32x16_bf16(paA, PK(m0, n0), o[1], 0, 0, 0);
                o[0] = __builtin_amdgcn_mfma_f32_32x32x16_bf16(paB, PK(l1, h1), o[0], 0, 0, 0);
                o[1] = __builtin_amdgcn_mfma_f32_32x32x16_bf16(paB, PK(m1, n1), o[1], 0, 0, 0);
#undef PK
            }
        }
        __syncthreads();
        if (ch == 0) { NA_WRITE(nB); __syncthreads(); }
    }
#undef NA_LOAD
#undef NA_WRITE
    LAS float* wsf = wsn;
    if (hi == 0) wsf[32 + r32] = l_reg; LDS_WAIT();
    { int le = lane; asm volatile("" : "+v"(le));
      LAS float* S = (LAS float*)(lds + NA_KOFF + wid * EPI_WAVE_BYTES);
      bf16_t* ob = c.proj + (size_t)s0 * LDP + C_NAQ + h * 64;
      auto rowoff = [&](int row) { return (size_t)((rA + (row >> 4)) * 64 + c0 + (row & 15)) * LDP; };
      u32x4 gw[2][2];
#pragma unroll
      for (int d0 = 0; d0 < 2; ++d0) epi_gates(gw[d0], le, ob + (C_NAG - C_NAQ) + d0 * 32, rowoff);
#pragma unroll
      for (int d0 = 0; d0 < 2; ++d0) epi_block(S, o[d0], wsf + 32, le, gw[d0], ob + d0 * 32, rowoff, DRY); }
    LDS_WAIT();
    __syncthreads();
}


typedef int v8i_t __attribute__((ext_vector_type(8)));
__device__ __forceinline__ int g8_slot(int k) { const int kk = k & 31; return 32 * ((kk >> 2) & 1) + (kk & 3) + 4 * (kk >> 3) + ((k >> 5) << 4); }
constexpr int G9_KB = 4224, G9_VB = 4096, G9_KOFF = 0, G9_VOFF = 4 * G9_KB, G9_WSOFF = G9_VOFF + 4 * G9_VB, G9_QOFF = G9_WSOFF + 2048;
static_assert(G9_QOFF + 8 * 6144 + 8 * EPI_WAVE_BYTES <= RING_BYTES, "gqa9 LDS map");
__device__ __forceinline__ void gqa9_unit(const Ctx& c, int s0, int slen, int kvh, int qb, LAS unsigned char* lds, const bool DRY) {
    const int tid = opaque_tid(), lane = tid & 63, r32 = lane & 31, hi = lane >> 5;
    const int wid = __builtin_amdgcn_readfirstlane(tid >> 6);
    LAS unsigned char* Kl = lds + G9_KOFF; LAS unsigned char* Vl = lds + G9_VOFF;
    LAS float* wsf = (LAS float*)(lds + G9_WSOFF) + wid * 64;
    const int tq = qb * 256 + wid * 32 + r32;
    const size_t Rq = (size_t)(s0 + tq);
    constexpr float CQ = 0.125f * LOG2E * 8.0f;
    LAS unsigned char* Qs = lds + G9_QOFF + wid * 6144 + lane * 16;
    {
        const f32x2* tb = (hi == 0) ? c.rowT + (tq >> 6) * 16 : c.colT + (tq & 63) * 16;
        const float* gqh = c.gq_norm + hi * 32;
#pragma nounroll
        for (int hh = 0; hh < 3; ++hh) {
            bf16x8 raw[4];
#pragma unroll
            for (int d = 0; d < 4; ++d) raw[d] = *(const bf16x8*)(c.proj + Rq * LDP + C_GQ + (kvh * 3 + hh) * 64 + hi * 32 + d * 8);
            float ss = 0.f;
#pragma unroll
            for (int i = 0; i < 32; ++i) { const float xv = bf2f(raw[i >> 3][i & 7]); ss += xv * xv; }
            ss += part32(ss);
            const float rstd = CQ / sqrtf(ss * (1.0f / 64.0f) + EPS);
            int qw[8];
#pragma unroll
            for (int w = 0; w < 4; ++w) {
                float y1[4], y2[4];
#pragma unroll
                for (int t = 0; t < 4; ++t) { const int e = 4 * w + t; const f32x2 cs = tb[e];
                    const float x1 = bf2f(raw[e >> 3][e & 7]) * rstd * gqh[e], x2 = bf2f(raw[(e + 16) >> 3][(e + 16) & 7]) * rstd * gqh[e + 16];
                    y1[t] = x1 * cs.x - x2 * cs.y; y2[t] = x2 * cs.x + x1 * cs.y; }
                int pa_ = 0, pb_ = 0;
                pa_ = __builtin_amdgcn_cvt_pk_fp8_f32(y1[0], y1[1], pa_, false); pa_ = __builtin_amdgcn_cvt_pk_fp8_f32(y1[2], y1[3], pa_, true);
                pb_ = __builtin_amdgcn_cvt_pk_fp8_f32(y2[0], y2[1], pb_, false); pb_ = __builtin_amdgcn_cvt_pk_fp8_f32(y2[2], y2[3], pb_, true);
                qw[w] = pa_; qw[4 + w] = pb_;
            }
            *(LAS u32x4*)(Qs + (hh * 2) * 1024) = (u32x4){(unsigned)qw[0], (unsigned)qw[1], (unsigned)qw[2], (unsigned)qw[3]};
            *(LAS u32x4*)(Qs + (hh * 2 + 1) * 1024) = (u32x4){(unsigned)qw[4], (unsigned)qw[5], (unsigned)qw[6], (unsigned)qw[7]};
        }
    }
    const int NT = slen >> 6;
    const bool isk = wid < 4;
    const unsigned char* gsrc = (isk ? c.kf8 : c.gv8) + ((size_t)(s0 >> 6) * 4 + kvh) * 4096 + (wid & 3) * 1024 + lane * 16;
    const unsigned ldst = isk ? (unsigned)(G9_KOFF + (wid & 3) * 1040) : (unsigned)(G9_VOFF + (wid & 3) * 1024);
    const int tadd = isk ? 3 : 2;
#define DMA9(t, off) __builtin_amdgcn_global_load_lds((const unsigned*)(gsrc + (size_t)(t) * 16384), (LAS unsigned*)(lds + ldst + (off)), 16, 0, 0)
#define V8I(a, b) ((v8i_t){(int)(a).x, (int)(a).y, (int)(a).z, (int)(a).w, (int)(b).x, (int)(b).y, (int)(b).z, (int)(b).w})
#define V8P(W) ((v8i_t){W[0], W[1], W[2], W[3], W[4], W[5], W[6], W[7]})
#define FN9(...) asm volatile("" : __VA_ARGS__ : : "memory")
#define EXPG9(P, w, PW, idx) do { const float e0_ = __builtin_amdgcn_exp2f(P[4 * (w)]), e1_ = __builtin_amdgcn_exp2f(P[4 * (w) + 1]), e2_ = __builtin_amdgcn_exp2f(P[4 * (w) + 2]), e3_ = __builtin_amdgcn_exp2f(P[4 * (w) + 3]); \
        int pk_ = PW[idx]; pk_ = __builtin_amdgcn_cvt_pk_bf8_f32(e0_, e1_, pk_, false); pk_ = __builtin_amdgcn_cvt_pk_bf8_f32(e2_, e3_, pk_, true); PW[idx] = pk_; } while (0)
#define MSUM9(ACC, PWX) ACC = __builtin_amdgcn_mfma_scale_f32_16x16x128_f8f6f4(V8P(PWX), onesB, ACC, 1, 0, 0, 0, 0, 0)
    float zf = 0.f; asm volatile("" : "+v"(zf));
    f32x4 lacc[3]; f32x16 o[3][2];
#pragma unroll
    for (int hh = 0; hh < 3; ++hh) lacc[hh] = (f32x4){zf, zf, zf, zf};
    v8i_t onesB;
    { int ov = (((lane & 15) == 0 && ((lane >> 4) & 1) == 0) || ((lane & 15) == 1 && ((lane >> 4) & 1) == 1)) ? 0x38383838 : 0; asm volatile("" : "+v"(ov));
#pragma unroll
      for (int w = 0; w < 8; ++w) onesB[w] = ov; }
#pragma unroll
    for (int hh = 0; hh < 3; ++hh)
#pragma unroll
        for (int r = 0; r < 16; ++r) { o[hh][0][r] = zf; o[hh][1][r] = zf; }
    const LAS unsigned char* kp0 = Kl + (2 * hi) * 1040 + r32 * 16;
    const int vsw = (r32 >> 2) & 3;
    const LAS unsigned char* vpa0 = Vl + r32 * 64 + (((2 * hi) ^ vsw) << 4);
    const LAS unsigned char* vpb0 = Vl + r32 * 64 + (((2 * hi + 1) ^ vsw) << 4);
    LAS unsigned char* Qr = Qs;
    { const unsigned z_ = __float_as_uint(zf); if (tid < 256) *(LAS u32x4*)(Vl + 3 * G9_VB + tid * 16) = (u32x4){z_, z_, z_, z_}; }
    DMA9(0, 0); DMA9(isk ? 1 : 0, isk ? G9_KB : 0); DMA9(isk ? 2 : 1, isk ? 2 * G9_KB : G9_VB);
    asm volatile("s_waitcnt vmcnt(1)" ::: "memory"); LDS_WAIT();
    __syncthreads();
    f32x16 pa0, pa1, pb0, pb1; int pwA[8], pwB[8];
#pragma unroll
    for (int w = 0; w < 8; ++w) { pwA[w] = __float_as_int(zf); pwB[w] = __float_as_int(zf); }
    { const u32x4 a0 = *(const LAS u32x4*)(kp0), a1 = *(const LAS u32x4*)(kp0 + 1040), b0 = *(const LAS u32x4*)(kp0 + 512), b1 = *(const LAS u32x4*)(kp0 + 1552);
      const u32x4 q0_ = *(const LAS u32x4*)(Qr), q1_ = *(const LAS u32x4*)(Qr + 1024);
      pa0 = __builtin_amdgcn_mfma_scale_f32_32x32x64_f8f6f4(V8I(a0, a1), V8I(q0_, q1_), (f32x16){}, 0, 0, 0, 0x7f7f7f7f, 0, 0x7c7c7c7c);
      pa1 = __builtin_amdgcn_mfma_scale_f32_32x32x64_f8f6f4(V8I(b0, b1), V8I(q0_, q1_), (f32x16){}, 0, 0, 0, 0x7f7f7f7f, 0, 0x7c7c7c7c); }
#define STEP9(P0, P1, N0, N1, PWP, PW, H, HP, VS, KS, HN, FIRST, LAST, J) do { \
        const LAS unsigned char* kp = kp0 + (KS) * G9_KB; const LAS unsigned char* vpa = vpa0 + (VS) * G9_VB; const LAS unsigned char* vpb = vpb0 + (VS) * G9_VB; \
        u32x4 c0 = *(const LAS u32x4*)(vpa), c1 = *(const LAS u32x4*)(vpb), d0_ = *(const LAS u32x4*)(vpa + 2048), d1_ = *(const LAS u32x4*)(vpb + 2048); \
        u32x4 ka0 = *(const LAS u32x4*)(kp), ka1 = *(const LAS u32x4*)(kp + 1040), qa0 = *(const LAS u32x4*)(Qr + (HN) * 2048), qa1 = *(const LAS u32x4*)(Qr + (HN) * 2048 + 1024); \
        u32x4 kb0 = *(const LAS u32x4*)(kp + 512), kb1 = *(const LAS u32x4*)(kp + 1552); \
        if (FIRST) { const int jt = (J) + tadd < NT ? (J) + tadd : NT - 1; DMA9(jt, isk ? (((J) + 3) & 3) * G9_KB : (((J) + 2) & 3) * G9_VB); } \
        FN9("+v"(P0)); \
        EXPG9(P0, 0, PW, 0); \
        FN9("+v"(c0), "+v"(c1), "+v"(o[HP][0]), "+v"(PW[0]), "+v"(P0)); \
        o[HP][0] = __builtin_amdgcn_mfma_scale_f32_32x32x64_f8f6f4(V8P(PWP), V8I(c0, c1), o[HP][0], 1, 0, 0, 0, 0, 0); EXPG9(P0, 1, PW, 1); \
        FN9("+v"(d0_), "+v"(d1_), "+v"(o[HP][1]), "+v"(PW[1]), "+v"(P0)); \
        o[HP][1] = __builtin_amdgcn_mfma_scale_f32_32x32x64_f8f6f4(V8P(PWP), V8I(d0_, d1_), o[HP][1], 1, 0, 0, 0, 0, 0); EXPG9(P0, 2, PW, 2); \
        FN9("+v"(PW[2]), "+v"(lacc[HP]), "+v"(P0)); \
        MSUM9(lacc[HP], PWP); EXPG9(P0, 3, PW, 3); \
        FN9("+v"(ka0), "+v"(ka1), "+v"(PW[3]), "+v"(P1)); \
        N0 = __builtin_amdgcn_mfma_scale_f32_32x32x64_f8f6f4(V8I(ka0, ka1), V8I(qa0, qa1), (f32x16){}, 0, 0, 0, 0x7f7f7f7f, 0, 0x7c7c7c7c); EXPG9(P1, 0, PW, 4); \
        FN9("+v"(PW[4]), "+v"(P1)); \
        EXPG9(P1, 1, PW, 5); \
        FN9("+v"(kb0), "+v"(kb1), "+v"(PW[5]), "+v"(P1)); \
        N1 = __builtin_amdgcn_mfma_scale_f32_32x32x64_f8f6f4(V8I(kb0, kb1), V8I(qa0, qa1), (f32x16){}, 0, 0, 0, 0x7f7f7f7f, 0, 0x7c7c7c7c); EXPG9(P1, 2, PW, 6); \
        FN9("+v"(PW[6]), "+v"(P1), "+v"(N0)); \
        EXPG9(P1, 3, PW, 7); \
        FN9("+v"(PW[7])); \
        if (LAST) { asm volatile("s_waitcnt vmcnt(1) lgkmcnt(0)" ::: "memory"); __builtin_amdgcn_s_barrier(); asm volatile("" ::: "memory"); } \
    } while (0)
#pragma nounroll
    for (int j = 0; j < NT; j += 2) {
        STEP9(pa0, pa1, pb0, pb1, pwA, pwB, 0, 2, (j + 3) & 3, j & 3, 1, true, false, j);
        STEP9(pb0, pb1, pa0, pa1, pwB, pwA, 1, 0, j & 3, j & 3, 2, false, false, j);
        STEP9(pa0, pa1, pb0, pb1, pwA, pwB, 2, 1, j & 3, (j + 1) & 3, 0, false, true, j);
        STEP9(pb0, pb1, pa0, pa1, pwB, pwA, 0, 2, j & 3, (j + 1) & 3, 1, true, false, j + 1);
        STEP9(pa0, pa1, pb0, pb1, pwA, pwB, 1, 0, (j + 1) & 3, (j + 1) & 3, 2, false, false, j + 1);
        STEP9(pb0, pb1, pa0, pa1, pwB, pwA, 2, 1, (j + 1) & 3, (j + 2) & 3, 0, false, true, j + 1);
    }
    { const LAS unsigned char* vpa = vpa0 + ((NT - 1) & 3) * G9_VB; const LAS unsigned char* vpb = vpb0 + ((NT - 1) & 3) * G9_VB;
      const u32x4 c0 = *(const LAS u32x4*)(vpa), c1 = *(const LAS u32x4*)(vpb), d0_ = *(const LAS u32x4*)(vpa + 2048), d1_ = *(const LAS u32x4*)(vpb + 2048);
      o[2][0] = __builtin_amdgcn_mfma_scale_f32_32x32x64_f8f6f4(V8P(pwA), V8I(c0, c1), o[2][0], 1, 0, 0, 0, 0, 0);
      o[2][1] = __builtin_amdgcn_mfma_scale_f32_32x32x64_f8f6f4(V8P(pwA), V8I(d0_, d1_), o[2][1], 1, 0, 0, 0, 0, 0);
      MSUM9(lacc[2], pwA); }
    LDS_WAIT();
#undef DMA9
#undef V8I
#undef V8P
#undef FN9
#undef EXPG9
#undef STEP9
#undef MSUM9
    int le = lane; asm volatile("" : "+v"(le));
    bf16_t* ob = c.proj + (size_t)(s0 + qb * 256 + wid * 32) * LDP;
    LAS float* S = (LAS float*)(lds + G9_QOFF + 8 * 6144 + wid * EPI_WAVE_BYTES);
    auto rowoff = [&](int row) { return (size_t)row * LDP; };
    u32x4 gw[3][2][2];
#pragma unroll
    for (int hh = 0; hh < 3; ++hh)
#pragma unroll
        for (int d0 = 0; d0 < 2; ++d0) epi_gates(gw[hh][d0], le, ob + C_GQG + (kvh * 3 + hh) * 64 + d0 * 32, rowoff);
#pragma unroll
    for (int hh = 0; hh < 3; ++hh) {
        if ((le & 15) < 2) *(LAS f32x4*)(wsf + 16 * (le & 15) + 4 * (le >> 4)) = lacc[hh];
        LDS_WAIT();
        const int ocol = C_GQ + (kvh * 3 + hh) * 64;
#pragma unroll
        for (int d0 = 0; d0 < 2; ++d0) epi_block(S, o[hh][d0], wsf, le, gw[hh][d0], ob + ocol + d0 * 32, rowoff, DRY);
        LDS_WAIT();
    }
    __syncthreads();
}


constexpr int M9_NR = 4;
constexpr int M9_KB = 12 * 1040 + 64, M9_VB = 8192, M9_KOFF = 0, M9_VOFF = M9_NR * M9_KB, M9_WSOFF = M9_VOFF + M9_NR * M9_VB, M9_QOFF = 0;
static_assert(M9_WSOFF + 2048 + 8 * EPI_WAVE_BYTES <= RING_BYTES && 8 * 6144 <= M9_WSOFF && M9_KB % 16 == 0, "mla9 LDS map");
__device__ __forceinline__ void mla9_unit(const Ctx& c, int s0, int slen, int h, int qb, LAS unsigned char* lds, const bool DRY) {
    const int tid = opaque_tid(), lane = tid & 63, r32 = lane & 31, hi = lane >> 5;
    const int wid = __builtin_amdgcn_readfirstlane(tid >> 6);
    LAS unsigned char* Kl = lds + M9_KOFF; LAS unsigned char* Vl = lds + M9_VOFF;
    LAS float* wsf = (LAS float*)(lds + M9_WSOFF) + wid * 64;
    LAS unsigned char* Qs = lds + M9_QOFF + wid * 6144 + lane * 16;
    const int tq = qb * 256 + wid * 32 + r32;
    const size_t Rq = (size_t)(s0 + tq);
    const int NT = slen >> 6;
    {
        const bf16_t* qp = c.q + Rq * LDQ + h * 192;
#pragma nounroll
        for (int b = 0; b < 2; ++b) {
            bf16x8 raw[4];
#pragma unroll
            for (int d = 0; d < 4; ++d) raw[d] = *(const bf16x8*)(qp + b * 64 + hi * 32 + d * 8);
            int qw[8];
#pragma unroll
            for (int w = 0; w < 8; ++w) { int pk = 0; pk = __builtin_amdgcn_cvt_pk_fp8_f32(bf2f(raw[w >> 1][(w & 1) * 4]) * 8.f, bf2f(raw[w >> 1][(w & 1) * 4 + 1]) * 8.f, pk, false);
                pk = __builtin_amdgcn_cvt_pk_fp8_f32(bf2f(raw[w >> 1][(w & 1) * 4 + 2]) * 8.f, bf2f(raw[w >> 1][(w & 1) * 4 + 3]) * 8.f, pk, true); qw[w] = pk; }
            *(LAS u32x4*)(Qs + (b * 2) * 1024) = (u32x4){(unsigned)qw[0], (unsigned)qw[1], (unsigned)qw[2], (unsigned)qw[3]};
            *(LAS u32x4*)(Qs + (b * 2 + 1) * 1024) = (u32x4){(unsigned)qw[4], (unsigned)qw[5], (unsigned)qw[6], (unsigned)qw[7]};
        }
        {
            bf16x8 ra[2], rb[2];
#pragma unroll
            for (int d = 0; d < 2; ++d) { ra[d] = *(const bf16x8*)(qp + 128 + hi * 16 + d * 8); rb[d] = *(const bf16x8*)(qp + 128 + 32 + hi * 16 + d * 8); }
            const f32x2* tb = c.ropeT + (size_t)tq * 32 + hi * 16;
            int qa[4], qb_[4];
#pragma unroll
            for (int w = 0; w < 4; ++w) { float y1[4], y2[4];
#pragma unroll
                for (int t = 0; t < 4; ++t) { const int e = 4 * w + t; const f32x2 cs = tb[e]; const float x1 = bf2f(ra[e >> 3][e & 7]) * 8.f, x2 = bf2f(rb[e >> 3][e & 7]) * 8.f;
                    y1[t] = x1 * cs.x - x2 * cs.y; y2[t] = x2 * cs.x + x1 * cs.y; }
                int pa_ = 0, pb_ = 0;
                pa_ = __builtin_amdgcn_cvt_pk_fp8_f32(y1[0], y1[1], pa_, false); pa_ = __builtin_amdgcn_cvt_pk_fp8_f32(y1[2], y1[3], pa_, true);
                pb_ = __builtin_amdgcn_cvt_pk_fp8_f32(y2[0], y2[1], pb_, false); pb_ = __builtin_amdgcn_cvt_pk_fp8_f32(y2[2], y2[3], pb_, true);
                qa[w] = pa_; qb_[w] = pb_; }
            *(LAS u32x4*)(Qs + 4 * 1024) = (u32x4){(unsigned)qa[0], (unsigned)qa[1], (unsigned)qa[2], (unsigned)qa[3]};
            *(LAS u32x4*)(Qs + 5 * 1024) = (u32x4){(unsigned)qb_[0], (unsigned)qb_[1], (unsigned)qb_[2], (unsigned)qb_[3]};
        }
    }
    const size_t T0 = (size_t)(s0 >> 6);
    const unsigned char* gkn = c.kn8 + (T0 * 6 + h) * 8192 + wid * 1024 + lane * 16;
    const unsigned char* gv = c.v8 + (T0 * 6 + h) * 8192 + wid * 1024 + lane * 16;
    const unsigned char* gkr = c.kr8 + T0 * 4096 + (wid & 3) * 1024 + lane * 16;
    const unsigned lkn = (unsigned)(M9_KOFF + wid * 1040), lkr = (unsigned)(M9_KOFF + (8 + (wid & 3)) * 1040), lv = (unsigned)(M9_VOFF + wid * 1024);
#define DMAK9(t, ring) do { __builtin_amdgcn_global_load_lds((const unsigned*)(gkn + (size_t)(t) * 49152), (LAS unsigned*)(lds + lkn + (ring) * M9_KB), 16, 0, 0); \
        __builtin_amdgcn_global_load_lds((const unsigned*)(gkr + (size_t)(t) * 4096), (LAS unsigned*)(lds + lkr + (ring) * M9_KB), 16, 0, 0); } while (0)
#define DMAV9(t, ring) __builtin_amdgcn_global_load_lds((const unsigned*)(gv + (size_t)(t) * 49152), (LAS unsigned*)(lds + lv + (ring) * M9_VB), 16, 0, 0)
#define SB9 __builtin_amdgcn_sched_barrier(0)
#define V8I(a, b) ((v8i_t){(int)(a).x, (int)(a).y, (int)(a).z, (int)(a).w, (int)(b).x, (int)(b).y, (int)(b).z, (int)(b).w})
#define RDKA9(D0, D1, blk) do { D0 = *(const LAS u32x4*)(kp + (blk) * 4160); D1 = *(const LAS u32x4*)(kp + (blk) * 4160 + 1040); } while (0)
#define RDKB9(D0, D1, blk) do { D0 = *(const LAS u32x4*)(kp + (blk) * 4160 + 512); D1 = *(const LAS u32x4*)(kp + (blk) * 4160 + 1552); } while (0)
#define RDQ9(D0, D1, blk) do { D0 = qr[2 * (blk)]; D1 = qr[2 * (blk) + 1]; } while (0)
#define RDV9(D0, D1, d0) do { D0 = *(const LAS u32x4*)(vpa + (d0) * 2048); D1 = *(const LAS u32x4*)(vpb + (d0) * 2048); } while (0)
#define MQK9(ACC, K0, K1, Q0, Q1, CIN) ACC = __builtin_amdgcn_mfma_scale_f32_32x32x64_f8f6f4(V8I(K0, K1), V8I(Q0, Q1), CIN, 0, 0, 0, 0x7f7f7f7f, 0, 0x7c7c7c7c)
#define V8P(W) ((v8i_t){W[0], W[1], W[2], W[3], W[4], W[5], W[6], W[7]})
#define MPV9(d0, V0, V1, PWP) o[d0] = __builtin_amdgcn_mfma_scale_f32_32x32x64_f8f6f4(PWP, V8I(V0, V1), o[d0], 0, 0, 0, 0, 0, 0)
#define EXPG9(P, w, PW, idx, SUB) do { float e0_ = P[4 * (w)], e1_ = P[4 * (w) + 1], e2_ = P[4 * (w) + 2], e3_ = P[4 * (w) + 3]; \
        if (SUB) { e0_ -= mhat; e1_ -= mhat; e2_ -= mhat; e3_ -= mhat; } \
        e0_ = __builtin_amdgcn_exp2f(e0_); e1_ = __builtin_amdgcn_exp2f(e1_); e2_ = __builtin_amdgcn_exp2f(e2_); e3_ = __builtin_amdgcn_exp2f(e3_); \
        int pk_ = PW[idx]; pk_ = __builtin_amdgcn_cvt_pk_fp8_f32(e0_, e1_, pk_, false); pk_ = __builtin_amdgcn_cvt_pk_fp8_f32(e2_, e3_, pk_, true); PW[idx] = pk_; } while (0)
    float zf = 0.f; asm volatile("" : "+v"(zf));
    float mhat = zf; f32x4 lacc = {zf, zf, zf, zf}; f32x16 o[4];
    v8i_t onesB;
    { int ov = (((lane & 15) == 0 && ((lane >> 4) & 1) == 0) || ((lane & 15) == 1 && ((lane >> 4) & 1) == 1)) ? 0x38383838 : 0; asm volatile("" : "+v"(ov));
#pragma unroll
      for (int w = 0; w < 8; ++w) onesB[w] = ov; }
#define MSUM9(PWX) lacc = __builtin_amdgcn_mfma_scale_f32_16x16x128_f8f6f4(V8P(PWX), onesB, lacc, 0, 0, 0, 0, 0, 0)
#pragma unroll
    for (int d = 0; d < 4; ++d)
#pragma unroll
        for (int r = 0; r < 16; ++r) o[d][r] = zf;
    u32x4 qr[6];
    LDS_WAIT();
#pragma unroll
    for (int i = 0; i < 6; ++i) qr[i] = *(const LAS u32x4*)(Qs + i * 1024);
    LDS_WAIT(); __syncthreads();
    const LAS unsigned char* kp0 = Kl + (2 * hi) * 1040 + r32 * 16;
    const int vsw = (r32 >> 2) & 3;
    const LAS unsigned char* vpa0 = Vl + r32 * 64 + (((2 * hi) ^ vsw) << 4);
    const LAS unsigned char* vpb0 = Vl + r32 * 64 + (((2 * hi + 1) ^ vsw) << 4);
    { const unsigned z_ = __float_as_uint(zf); for (int i = tid * 16; i < M9_VB; i += 8192) *(LAS u32x4*)(Vl + 3 * M9_VB + i) = (u32x4){z_, z_, z_, z_}; }
    DMAK9(0, 0); DMAK9(1, 1);
    DMAK9(2, 2); DMAV9(0, 0);
    DMAK9(3, 3); DMAV9(1, 1);
    asm volatile("s_waitcnt vmcnt(6)" ::: "memory"); LDS_WAIT();
    __syncthreads();
    f32x16 pa0, pa1, pb0, pb1; int pwA[8], pwB[8];
#pragma unroll
    for (int w = 0; w < 8; ++w) { pwA[w] = __float_as_int(zf); pwB[w] = __float_as_int(zf); }
    { const LAS unsigned char* kp = kp0;
#pragma unroll
      for (int blk = 0; blk < 3; ++blk) { u32x4 a0, a1, b0, b1, q0_, q1_; RDKA9(a0, a1, blk); RDKB9(b0, b1, blk); RDQ9(q0_, q1_, blk);
          if (blk == 0) { MQK9(pa0, a0, a1, q0_, q1_, (f32x16){}); MQK9(pa1, b0, b1, q0_, q1_, (f32x16){}); } else { MQK9(pa0, a0, a1, q0_, q1_, pa0); MQK9(pa1, b0, b1, q0_, q1_, pa1); } } }
    LDS_WAIT();
    __syncthreads();
    int kro = M9_KB, vro = 3 * M9_VB, dko = 0, dvo = 2 * M9_VB;
#define FN9(...) asm volatile("" : __VA_ARGS__ : : "memory")
#define REST9(P0, P1, N0, N1, PWP, PW, J, SUB) do { \
        u32x4 c0, c1, d0_, d1_, g0, g1, t0_, t1_; \
        FN9("+v"(ka0), "+v"(ka1), "+v"(P0)); \
        MQK9(N0, ka0, ka1, qa0, qa1, (f32x16){}); RDKA9(c0, c1, 1); RDQ9(g0, g1, 1); EXPG9(P0, 0, PW, 0, SUB); \
        FN9("+v"(kb0), "+v"(kb1), "+v"(PW[0]), "+v"(P0)); \
        MQK9(N1, kb0, kb1, qa0, qa1, (f32x16){}); RDKB9(d0_, d1_, 1); EXPG9(P0, 1, PW, 1, SUB); \
        FN9("+v"(c0), "+v"(c1), "+v"(N0), "+v"(PW[1]), "+v"(P0)); \
        MQK9(N0, c0, c1, g0, g1, N0); RDKA9(ka0, ka1, 2); RDQ9(qa0, qa1, 2); EXPG9(P0, 2, PW, 2, SUB); \
        FN9("+v"(d0_), "+v"(d1_), "+v"(N1), "+v"(PW[2]), "+v"(P0)); \
        MQK9(N1, d0_, d1_, g0, g1, N1); RDKB9(kb0, kb1, 2); EXPG9(P0, 3, PW, 3, SUB); \
        FN9("+v"(ka0), "+v"(ka1), "+v"(N0), "+v"(PW[3]), "+v"(P1)); \
        MQK9(N0, ka0, ka1, qa0, qa1, N0); RDV9(c0, c1, 0); EXPG9(P1, 0, PW, 4, SUB); \
        FN9("+v"(kb0), "+v"(kb1), "+v"(N1), "+v"(PW[4]), "+v"(P1)); \
        MQK9(N1, kb0, kb1, qa0, qa1, N1); RDV9(d0_, d1_, 1); EXPG9(P1, 1, PW, 5, SUB); \
        FN9("+v"(c0), "+v"(c1), "+v"(o[0]), "+v"(PW[5]), "+v"(P1)); \
        MPV9(0, c0, c1, V8P(PWP)); RDV9(g0, g1, 2); EXPG9(P1, 2, PW, 6, SUB); \
        FN9("+v"(d0_), "+v"(d1_), "+v"(o[1]), "+v"(PW[6]), "+v"(P1)); \
        MPV9(1, d0_, d1_, V8P(PWP)); RDV9(t0_, t1_, 3); EXPG9(P1, 3, PW, 7, SUB); \
        FN9("+v"(g0), "+v"(g1), "+v"(o[2]), "+v"(PW[7])); \
        MPV9(2, g0, g1, V8P(PWP)); \
        FN9("+v"(t0_), "+v"(t1_), "+v"(o[3]), "+v"(lacc)); \
        MSUM9(PWP); \
        MPV9(3, t0_, t1_, V8P(PWP)); { const int jk = (J) + 4 < NT ? (J) + 4 : NT - 1, jv = (J) + 2 < NT ? (J) + 2 : NT - 1; \
            __builtin_amdgcn_global_load_lds((const unsigned*)(gkn + (size_t)jk * 49152), (LAS unsigned*)(lds + lkn + dko), 16, 0, 0); \
            __builtin_amdgcn_global_load_lds((const unsigned*)(gkr + (size_t)jk * 4096), (LAS unsigned*)(lds + lkr + dko), 16, 0, 0); \
            __builtin_amdgcn_global_load_lds((const unsigned*)(gv + (size_t)jv * 49152), (LAS unsigned*)(lds + lv + dvo), 16, 0, 0); } \
        FN9("+v"(N0), "+v"(N1), "+v"(o[0]), "+v"(o[1])); \
    } while (0)
#define BODY9(P0, P1, N0, N1, PWP, PW, J) do { \
        const LAS unsigned char* kp = kp0 + kro; const LAS unsigned char* vpa = vpa0 + vro; const LAS unsigned char* vpb = vpb0 + vro; \
        u32x4 ka0, ka1, kb0, kb1, qa0, qa1; \
        RDKA9(ka0, ka1, 0); RDQ9(qa0, qa1, 0); RDKB9(kb0, kb1, 0); \
        float a_ = fmaxf(fmaxf(P0[0], P0[1]), P1[0]), b_ = fmaxf(fmaxf(P0[2], P0[3]), P1[1]); a_ = fmaxf(fmaxf(a_, P1[2]), P1[3]); \
        _Pragma("unroll") for (int r = 4; r < 16; r += 4) { a_ = fmaxf(fmaxf(a_, P0[r]), P0[r + 1]); b_ = fmaxf(fmaxf(b_, P0[r + 2]), P0[r + 3]); a_ = fmaxf(fmaxf(a_, P1[r]), P1[r + 1]); b_ = fmaxf(fmaxf(b_, P1[r + 2]), P1[r + 3]); } \
        float rm = fmaxf(a_, b_); rm = fmaxf(rm, part32(rm)); \
        float alpha = 1.f; const bool first = ((J) == 0); \
        const bool okl = first ? (rm <= THR2 && rm >= -4.f) : (rm - mhat <= THR2);     \
        if (__builtin_expect(!__all(okl), 0)) { const float mn = first ? rm : fmaxf(mhat, rm); alpha = first ? 1.f : __builtin_amdgcn_exp2f(mhat - mn); mhat = mn; } \
        if (__builtin_expect(__any(mhat != 0.f), 0)) { _Pragma("unroll") for (int r = 0; r < 16; ++r) { P0[r] -= mhat; P1[r] -= mhat; } } \
        REST9(P0, P1, N0, N1, PWP, PW, J, false); \
        if (__builtin_expect(__any(alpha < 1.f), 0)) { if (hi == 0) wsf[r32] = alpha; LDS_WAIT(); \
            _Pragma("unroll") for (int d = 0; d < 4; ++d) _Pragma("unroll") for (int r = 0; r < 16; ++r) o[d][r] *= wsf[crow(r, hi)]; \
            lacc *= *(const LAS f32x4*)(wsf + 16 * (lane & 1) + 4 * (lane >> 4)); LDS_WAIT(); } \
        { const int t_ = kro + M9_KB; kro = t_ == M9_NR * M9_KB ? 0 : t_; const int u_ = vro + M9_VB; vro = u_ == M9_NR * M9_VB ? 0 : u_; \
          const int v_ = dko + M9_KB; dko = v_ == M9_NR * M9_KB ? 0 : v_; const int w_ = dvo + M9_VB; dvo = w_ == M9_NR * M9_VB ? 0 : w_; } \
        asm volatile("s_waitcnt vmcnt(6) lgkmcnt(0)" ::: "memory"); __builtin_amdgcn_s_barrier(); asm volatile("" ::: "memory"); \
    } while (0)
#pragma nounroll
    for (int j = 0; j < NT; j += 2) {
        BODY9(pa0, pa1, pb0, pb1, pwA, pwB, j);
        BODY9(pb0, pb1, pa0, pa1, pwB, pwA, j + 1);
    }
    { const LAS unsigned char* vpa = vpa0 + vro; const LAS unsigned char* vpb = vpb0 + vro; u32x4 c0, c1, d0_, d1_, g0, g1, t0_, t1_;
      RDV9(c0, c1, 0); RDV9(d0_, d1_, 1); RDV9(g0, g1, 2); RDV9(t0_, t1_, 3);
      MPV9(0, c0, c1, V8P(pwA)); MPV9(1, d0_, d1_, V8P(pwA)); MPV9(2, g0, g1, V8P(pwA)); MPV9(3, t0_, t1_, V8P(pwA)); MSUM9(pwA); }
    VM_WAIT();
#undef DMAK9
#undef DMAV9
#undef SB9
#undef V8I
#undef RDKA9
#undef RDKB9
#undef RDQ9
#undef RDV9
#undef MQK9
#undef MPV9
#undef EXPG9
#undef REST9
#undef BODY9
#undef MSUM9
#undef FN9
#undef V8P
    LDS_WAIT(); if ((lane & 15) < 2) *(LAS f32x4*)(wsf + 32 + 16 * (lane & 15) + 4 * (lane >> 4)) = lacc; LDS_WAIT();
    { int le = lane; asm volatile("" : "+v"(le));
      bf16_t* ob = c.proj + (size_t)(s0 + qb * 256 + wid * 32) * LDP + C_MLAG + h * 128;
      LAS float* S = (LAS float*)(lds + M9_WSOFF + 2048 + wid * EPI_WAVE_BYTES);
      auto rowoff = [&](int row) { return (size_t)row * LDP; };
      u32x4 gw[4][2];
#pragma unroll
      for (int d0 = 0; d0 < 4; ++d0) epi_gates(gw[d0], le, ob + d0 * 32, rowoff);
#pragma unroll
      for (int d0 = 0; d0 < 4; ++d0) epi_block(S, o[d0], wsf + 32, le, gw[d0], ob + d0 * 32, rowoff, DRY); }
    LDS_WAIT();
    __syncthreads();
}


template <int KIND> __device__ __forceinline__ void attn_unit(const Ctx& c, int s0, int slen, int h, int qb, LAS unsigned char* lds, const bool DRY) {
    constexpr int NDQ = Cfg<KIND>::NDQ, NDV = Cfg<KIND>::NDV, KB = 2 * NDQ * 1040, VB = NDV * 4096;
    constexpr float SC = Cfg<KIND>::SCALE;
    const int tid = opaque_tid(), lane = tid & 63, r32 = lane & 31, hi = lane >> 5;
    const int wid = __builtin_amdgcn_readfirstlane(tid >> 6);
    LAS unsigned char* Kl = lds + A_KOFF; LAS unsigned char* Vl = lds + A_VOFF;
    LAS float* wsf = (LAS float*)(lds + A_WSOFF) + wid * 64;
    LAS float* bl = (LAS float*)(lds + A_BOFF);
    const int tq = qb * 256 + wid * 32 + r32;
    const size_t Rq = (size_t)(s0 + tq);
    int NT, kt0; int rsw = 0, rq = 0, cq = 0, csq = 0;
    if (KIND == 2) {
        const int rows = slen >> 6, r0 = qb * 4;
        const int lo = min(max(r0 - 4, 0), rows - 8), hi_r = min(max(r0 + 3 - 4, 0), rows - 8) + 7;
        NT = hi_r - lo + 1; kt0 = lo * 64;
        rq = r0 + (wid >> 1); rsw = min(max(rq - 4, 0), rows - 8);
        cq = 32 * (wid & 1) + r32; csq = min(max(cq - 8, 0), 48);
        for (int i = tid; i < 15 * 32; i += 512) { const int di = i >> 5, dj = i & 31; bl[i] = (dj < 31) ? c.rpb[(h * 15 + di) * 31 + dj] * (1.0f / SC) : 0.f; }
    } else { NT = slen >> 6; kt0 = 0; }
    bf16x8 qr[NDQ];
    if (KIND == 0) {
        const bf16_t* qp = c.q + Rq * LDQ + h * 192 + hi * 8;
#pragma unroll
        for (int d0 = 0; d0 < 12; ++d0) qr[d0] = *(const bf16x8*)(qp + d0 * 16);
        const f32x2* tb = c.ropeT + (size_t)tq * 32 + hi * 8;
#pragma unroll
        for (int a = 0; a < 2; ++a) {
            unsigned w1[4], w2[4];
#pragma unroll
            for (int i = 0; i < 8; i += 2) {
                const f32x2 cs0 = tb[a * 16 + i], cs1 = tb[a * 16 + i + 1];
                const float x10 = bf2f(qr[8 + a][i]), x11 = bf2f(qr[8 + a][i + 1]), x20 = bf2f(qr[10 + a][i]), x21 = bf2f(qr[10 + a][i + 1]);
                w1[i >> 1] = cvt_pk_bf16(x10 * cs0.x - x20 * cs0.y, x11 * cs1.x - x21 * cs1.y);
                w2[i >> 1] = cvt_pk_bf16(x20 * cs0.x + x10 * cs0.y, x21 * cs1.x + x11 * cs1.y);
            }
            qr[8 + a] = __builtin_bit_cast(bf16x8, (u32x4){w1[0], w1[1], w1[2], w1[3]});
            qr[10 + a] = __builtin_bit_cast(bf16x8, (u32x4){w2[0], w2[1], w2[2], w2[3]});
        }
    } else if (KIND == 1) {
        const bf16_t* qp = c.proj + Rq * LDP + C_GQ + h * 64 + hi * 8;
        float x[4][8]; float ss = 0.f;
#pragma unroll
        for (int d0 = 0; d0 < 4; ++d0) { const bf16x8 v = *(const bf16x8*)(qp + d0 * 16);
#pragma unroll
            for (int i = 0; i < 8; ++i) { x[d0][i] = bf2f(v[i]); ss += x[d0][i] * x[d0][i]; } }
        ss += part32(ss);
        const float rstd = 1.0f / sqrtf(ss * (1.0f / 64.0f) + EPS);
#pragma unroll
        for (int d0 = 0; d0 < 4; ++d0)
#pragma unroll
            for (int i = 0; i < 8; ++i) x[d0][i] *= rstd * c.gq_norm[d0 * 16 + hi * 8 + i];
        const f32x2* tr = c.rowT + (tq >> 6) * 16 + hi * 8; const f32x2* tc = c.colT + (tq & 63) * 16 + hi * 8;
#pragma unroll
        for (int a = 0; a < 2; ++a) {
            unsigned w1[4], w2[4];
#pragma unroll
            for (int i = 0; i < 8; i += 2) {
                const f32x2 cs0 = a ? tc[i] : tr[i], cs1 = a ? tc[i + 1] : tr[i + 1];
                const float x10 = x[2 * a][i], x11 = x[2 * a][i + 1], x20 = x[2 * a + 1][i], x21 = x[2 * a + 1][i + 1];
                w1[i >> 1] = cvt_pk_bf16(x10 * cs0.x - x20 * cs0.y, x11 * cs1.x - x21 * cs1.y);
                w2[i >> 1] = cvt_pk_bf16(x20 * cs0.x + x10 * cs0.y, x21 * cs1.x + x11 * cs1.y);
            }
            qr[2 * a] = __builtin_bit_cast(bf16x8, (u32x4){w1[0], w1[1], w1[2], w1[3]});
            qr[2 * a + 1] = __builtin_bit_cast(bf16x8, (u32x4){w2[0], w2[1], w2[2], w2[3]});
        }
    } else {
        const bf16_t* qp = c.proj + Rq * LDP + C_NAQ + h * 64 + hi * 8;
#pragma unroll
        for (int d0 = 0; d0 < 4; ++d0) qr[d0] = *(const bf16x8*)(qp + d0 * 16);
    }
    const size_t krow0 = (size_t)(s0 + kt0);
    const bf16_t *gk0, *gk1 = nullptr, *gk2 = nullptr, *gv0, *gv1 = nullptr;
    int lk0, lk1 = 0, lk2 = 0, lv0, lv1 = 0; size_t kstride, vstride, k2stride = 0;
    if (KIND == 0) {
        const int ka = tid >> 4, ca = tid & 15, kb2 = 32 + ka;
        gk0 = c.kv + (krow0 + ka) * LDKV + h * 256 + ca * 8; gk1 = c.kv + (krow0 + kb2) * LDKV + h * 256 + ca * 8; kstride = (size_t)64 * LDKV;
        lk0 = ca * 1040 + ka * 16; lk1 = ca * 1040 + kb2 * 16;
        const int kr = tid >> 3, cr = tid & 7;
        gk2 = c.proj + (krow0 + kr) * LDP + C_KR + cr * 8; k2stride = (size_t)64 * LDP; lk2 = (16 + cr) * 1040 + kr * 16;
        gv0 = c.kv + (krow0 + ka) * LDKV + h * 256 + 128 + ca * 8; gv1 = c.kv + (krow0 + kb2) * LDKV + h * 256 + 128 + ca * 8; vstride = (size_t)64 * LDKV;
        lv0 = v_st<NDV>(ka, ca * 8); lv1 = v_st<NDV>(kb2, ca * 8);
    } else {
        const int kr = tid >> 3, cr = tid & 7;
        const int kcol = (KIND == 1) ? C_GK + (h / 3) * 64 : C_NAK + h * 64, vcol = (KIND == 1) ? C_GV + (h / 3) * 64 : C_NAV + h * 64;
        gk0 = c.proj + (krow0 + kr) * LDP + kcol + cr * 8; gv0 = c.proj + (krow0 + kr) * LDP + vcol + cr * 8; kstride = vstride = (size_t)64 * LDP;
        lk0 = cr * 1040 + kr * 16; lv0 = v_st<NDV>(kr, cr * 8);
    }
    bf16x8 sk0, sk1, sk2, sv0, sv1;
#define SLOAD(j) do { sk0 = *(const bf16x8*)(gk0 + (size_t)(j) * kstride); sv0 = *(const bf16x8*)(gv0 + (size_t)(j) * vstride); \
        if (KIND == 0) { sk1 = *(const bf16x8*)(gk1 + (size_t)(j) * kstride); sk2 = *(const bf16x8*)(gk2 + (size_t)(j) * k2stride); sv1 = *(const bf16x8*)(gv1 + (size_t)(j) * vstride); } } while (0)
#define SWRITE(b) do { *(LAS bf16x8*)(Kl + (b) * KB + lk0) = sk0; *(LAS bf16x8*)(Vl + (b) * VB + lv0) = sv0; \
        if (KIND == 0) { *(LAS bf16x8*)(Kl + (b) * KB + lk1) = sk1; *(LAS bf16x8*)(Kl + (b) * KB + lk2) = sk2; *(LAS bf16x8*)(Vl + (b) * VB + lv1) = sv1; } } while (0)
    float m_reg = (KIND == 0) ? 0.f : -1e30f, l_reg = 0.f; f32x16 o[NDV];
#pragma unroll
    for (int d = 0; d < NDV; ++d) o[d] = f32x16{};
    SLOAD(0); SWRITE(0); if (NT > 1) SLOAD(1);
    __syncthreads();
    const LAS unsigned char* vp0 = Vl + v_rd_base(lane);
    for (int j = 0; j < NT; ++j) {
        const int b = j & 1;
        bool act = true; int di = 0;
        if (KIND == 2) { const int kr = (kt0 >> 6) + j; act = (kr >= rsw) && (kr < rsw + 8); di = kr - rq + 7; }
        if (act) {
            f32x16 p0, p1; bf16x8 pa0, pa1, pa2, pa3; float alpha;
            qkt<NDQ>(p0, p1, Kl + b * KB, qr, r32, hi);
            if (j + 1 < NT) SWRITE(b ^ 1);
            if (j + 2 < NT) SLOAD(j + 2);
            const LAS unsigned char* vp = vp0 + b * VB;
            VF fa; v_read<NDV, 0>(fa, vp);
            if (KIND == 2) {
                const LAS float* br = bl + di * 32 + (15 - cq);
#pragma unroll
                for (int r = 0; r < 16; ++r) { const int k0_ = crow(r, hi), k1_ = 32 + k0_;
                    const bool v0 = (k0_ >= csq) && (k0_ < csq + 16), v1 = (k1_ >= csq) && (k1_ < csq + 16);
                    const float b0_ = br[v0 ? k0_ : cq], b1_ = br[v1 ? k1_ : cq];
                    p0[r] = v0 ? p0[r] + b0_ : -INFINITY; p1[r] = v1 ? p1[r] + b1_ : -INFINITY; }
            }
            if (KIND == 0) softmax_ref(p0, p1, m_reg, l_reg, alpha, j == 0, pa0, pa1, pa2, pa3); else softmax_tile<KIND>(p0, p1, m_reg, l_reg, alpha, pa0, pa1, pa2, pa3);
            if (__any(alpha < 1.f)) { if (hi == 0) wsf[r32] = alpha; LDS_WAIT();
#pragma unroll
                for (int d = 0; d < NDV; ++d)
#pragma unroll
                    for (int r = 0; r < 16; ++r) o[d][r] *= wsf[crow(r, hi)];
                LDS_WAIT(); }
            SBAR();
            VF fb; v_read<NDV, 1>(fb, vp); SBAR();
            pv_mma(o[0], fa, pa0, pa1, pa2, pa3); SBAR();
            if (NDV == 4) { v_read<NDV, 2>(fa, vp); SBAR(); pv_mma(o[1], fb, pa0, pa1, pa2, pa3); SBAR(); v_read<NDV, 3>(fb, vp); SBAR(); pv_mma(o[NDV - 2], fa, pa0, pa1, pa2, pa3); SBAR(); pv_mma(o[NDV - 1], fb, pa0, pa1, pa2, pa3); }
            else pv_mma(o[1], fb, pa0, pa1, pa2, pa3);
            SBAR();
        } else {
            if (j + 1 < NT) SWRITE(b ^ 1);
            if (j + 2 < NT) SLOAD(j + 2);
        }
        __syncthreads();
    }
#undef SLOAD
#undef SWRITE
    if (hi == 0) wsf[32 + r32] = l_reg; LDS_WAIT();
    const int ocol = (KIND == 0) ? C_MLAG + h * 128 : (KIND == 1) ? C_GQ + h * 64 : C_NAQ + h * 64;
    const int gcol = (KIND == 0) ? C_MLAG + h * 128 : (KIND == 1) ? C_GQG + h * 64 : C_NAG + h * 64;
    int r32e = r32; asm volatile("" : "+v"(r32e));
    bf16_t* obase = c.proj + (size_t)(s0 + qb * 256 + wid * 32) * LDP + r32e;
#pragma unroll
    for (int r = 0; r < 16; ++r) { const int orow = crow(r, hi); const float rl = __builtin_amdgcn_rcpf(wsf[32 + orow]);
#pragma unroll
        for (int d0 = 0; d0 < NDV; ++d0) { const float gt = bf2f((short)obase[(size_t)orow * LDP + gcol + d0 * 32]);
            const float y = o[d0][r] * rl * gt * __builtin_amdgcn_rcpf(1.f + __builtin_amdgcn_exp2f(-gt * LOG2E));
            if (!DRY) obase[(size_t)orow * LDP + ocol + d0 * 32] = (bf16_t)(cvt_pk_bf16(y, 0.f) & 0xffffu); } }
    LDS_WAIT();
    __syncthreads();
}
}

#define XB_TMO      128
#define XB_XCNT(j)  (256  + 64 * (j))
#define XB_XSUB(j)  (1280 + 64 * (j))
#define XB_XGEN(j)  (2304 + 64 * (j))
#define XB_TOP      3328
#define XB_TOPGEN   3392
#define XCD_BAR_WORDS 3456
#define XB_SPIN_CAP (1u << 20)
__device__ __forceinline__ unsigned xb_ld(unsigned* p)              { return __hip_atomic_load(p, __ATOMIC_RELAXED, __HIP_MEMORY_SCOPE_AGENT); }
__device__ __forceinline__ unsigned xb_add(unsigned* p, unsigned v) { return __hip_atomic_fetch_add(p, v, __ATOMIC_RELAXED, __HIP_MEMORY_SCOPE_AGENT); }
__device__ __forceinline__ unsigned xb_xcc_id() { return (unsigned)__builtin_amdgcn_s_getreg((3 << 11) | 20) & 0xFu; }
#define XB_SPIN(cond, bar) do { unsigned _sp = 0; while (cond) { __builtin_amdgcn_s_sleep(1); \
    if ((++_sp & 255u) == 0u) { if (xb_ld(&(bar)[XB_TMO])) break; if (_sp > XB_SPIN_CAP) { atomicAdd(&(bar)[XB_TMO], 1u); break; } } } } while (0)
struct XcdBarrier { unsigned* bar; unsigned x; volatile LAS unsigned* st; };
__device__ __forceinline__ XcdBarrier xcd_barrier_post(unsigned* bar, volatile LAS unsigned* st) {
    XcdBarrier b; b.bar = bar; b.x = xb_xcc_id(); b.st = st;
    if (threadIdx.x == 0) (void)xb_add(&bar[XB_XCNT(b.x)], 1u);
    return b;
}
__device__ __forceinline__ void xcd_barrier_complete(unsigned* bar, unsigned x, unsigned& nloc, unsigned& nx) {
    const unsigned G = gridDim.x * gridDim.y * gridDim.z;
    unsigned sum, cnt, mine, sp = 0u;
    for (;;) {
        sum = 0u; cnt = 0u; mine = 0u;
#pragma unroll
        for (unsigned j = 0; j < 16; ++j) { const unsigned c = xb_ld(&bar[XB_XCNT(j)]); sum += c; cnt += (c > 0u) ? 1u : 0u; mine = (j == x) ? c : mine; }
        if (sum == G) break;
        __builtin_amdgcn_s_sleep(1);
        if ((++sp & 255u) == 0u) { if (xb_ld(&bar[XB_TMO])) break; if (sp > XB_SPIN_CAP) { atomicAdd(&bar[XB_TMO], 1u); break; } }
    }
    nloc = mine > 0u ? mine : 1u; nx = cnt > 0u ? cnt : 1u;
}
__device__ __forceinline__ void xcd_barrier(const XcdBarrier& b) {
    asm volatile("s_waitcnt vmcnt(0)" ::: "memory");
    __syncthreads();
    if (threadIdx.x == 0) {
        unsigned* bar = b.bar;
        __builtin_amdgcn_s_waitcnt(0);
        unsigned nloc = b.st[0], nx = b.st[1];
        if (nloc == 0u) { xcd_barrier_complete(bar, b.x, nloc, nx); b.st[0] = nloc; b.st[1] = nx; }
        const unsigned old = xb_add(&bar[XB_XSUB(b.x)], 1u);
        const unsigned gen = old / nloc;
        if (old + 1u == (gen + 1u) * nloc) {
            __builtin_amdgcn_fence(__ATOMIC_RELEASE, "agent");
            asm volatile("s_waitcnt vmcnt(0)" ::: "memory");
            const unsigned og = xb_add(&bar[XB_TOP], 1u);
            const unsigned tg = og / nx;
            if (og + 1u == (tg + 1u) * nx) xb_add(&bar[XB_TOPGEN], 1u);
            else XB_SPIN(xb_ld(&bar[XB_TOPGEN]) == tg, bar);
            __builtin_amdgcn_fence(__ATOMIC_ACQUIRE, "agent");
            xb_add(&bar[XB_XGEN(b.x)], 1u);
            asm volatile("s_waitcnt vmcnt(0)" ::: "memory");
        } else {
            XB_SPIN(xb_ld(&bar[XB_XGEN(b.x)]) == gen, bar);
            __builtin_amdgcn_fence(__ATOMIC_ACQUIRE, "agent");
            asm volatile("s_waitcnt vmcnt(0)" ::: "memory");
        }
    }
    __syncthreads();
}

struct Args {
    const float* xp; const float* xs; const float* pp; const float* ps; const float* norm_g; const float* w_in; const float* na_rpb; const float* q_a_norm; const float* w_q_b;
    const float* kv_a_norm; const float* w_kv_b; const float* gq_norm; const float* gk_norm; const float* w_out; const float* ple_norm; const float* w_pe; const float* w_pg; const float* final_norm;
    float* out; unsigned char* ws; int ph_lo, ph_hi;
};
constexpr int NPHASE = 24;

__device__ __forceinline__ const float* x_row(const Args& a, int grow) { return grow < SEQ_P ? a.xp + (size_t)grow * DM : a.xs + (size_t)(grow - SEQ_P) * DM; }

__device__ __forceinline__ void tr_item(const float* W, int Nsrc, int n_src0, const float* gain, bf16_t* WT, int K, int k0, int n_dst0, bool zero, LAS float* scr, int lane, float mul = 1.0f, bool f16 = false) {
    f32x4 wv[8];
#pragma unroll
    for (int i = 0; i < 8; ++i) { const int kk = 8 * i + (lane >> 3); wv[i] = (f32x4){0.f, 0.f, 0.f, 0.f};
        if (!zero) wv[i] = *(const f32x4*)(W + (size_t)(k0 + kk) * Nsrc + n_src0 + 4 * (lane & 7)); }
#pragma unroll
    for (int i = 0; i < 8; ++i) { const int kk = 8 * i + (lane >> 3); const float gm = (!zero && gain) ? gain[k0 + kk] * mul : mul;
#pragma unroll
        for (int j = 0; j < 4; ++j) scr[kk * 33 + 4 * (lane & 7) + j] = wv[i][j] * gm; }
    LDS_WAIT(); asm volatile("" ::: "memory");
    const int cc = lane & 7;
#pragma unroll
    for (int j = 0; j < 4; ++j) { const int n = (lane >> 3) + 8 * j; const LAS float* s = scr + (8 * cc) * 33 + n;
        u32x4 o;
        if (f16) { o.x = cvt_pk_f16(s[0 * 33], s[1 * 33]); o.y = cvt_pk_f16(s[2 * 33], s[3 * 33]); o.z = cvt_pk_f16(s[4 * 33], s[5 * 33]); o.w = cvt_pk_f16(s[6 * 33], s[7 * 33]); }
        else { o.x = cvt_pk_bf16(s[0 * 33], s[1 * 33]); o.y = cvt_pk_bf16(s[2 * 33], s[3 * 33]); o.z = cvt_pk_bf16(s[4 * 33], s[5 * 33]); o.w = cvt_pk_bf16(s[6 * 33], s[7 * 33]); }
        *(u32x4*)(WT + (size_t)(n_dst0 + n) * K + k0 + 8 * cc) = o; }
    LDS_WAIT(); asm volatile("" ::: "memory");
}
__device__ __forceinline__ int proj_src_col(int n) {
    if (n < C_MLAG) return n;
    if (n < C_GQ) return 2880 + (n - C_MLAG);
    if (n < C_NAK) return 3648 + (n - C_GQ);
    if (n < C_NAV) return 512 + (n - C_NAK);
    if (n < C_NAG) return 1024 + (n - C_NAV);
    if (n < C_CQ) return 1536 + (n - C_NAG);
    if (n < C_CKV) return 2048 + (n - C_CQ);
    if (n < C_GK) return 2560 + (n - C_CKV);
    if (n < C_GV) return 4416 + (n - C_GK);
    if (n < C_GQG) return 4672 + (n - C_GV);
    if (n < C_KR) return 4928 + (n - C_GQG);
    return 2816 + (n - C_KR);
}
__device__ __forceinline__ void sincos_d(double a, float& c, float& s) {
    const double k = __builtin_rint(a * 0.15915494309189535);
    double r = __builtin_fma(-k, 6.283185307179586, a); r = __builtin_fma(-k, 2.4492935982947064e-16, r);
    const double r2 = r * r; double sn = 1.0, cs = 1.0;
#pragma unroll
    for (int i = 12; i >= 1; --i) { sn = 1.0 - r2 * (1.0 / (double)((2 * i) * (2 * i + 1))) * sn; cs = 1.0 - r2 * (1.0 / (double)((2 * i - 1) * (2 * i))) * cs; }
    s = (float)(r * sn); c = (float)cs;
}

__global__ void __launch_bounds__(512, 2) fwd(Args a) {
    extern __shared__ __attribute__((aligned(16))) unsigned char lds_raw[];
    LAS unsigned char* lds = (LAS unsigned char*)lds_raw;
    volatile LAS unsigned* MISC = (volatile LAS unsigned*)(lds + MISC_OFF);
    const int tid = threadIdx.x, lane = tid & 63, wave = __builtin_amdgcn_readfirstlane(tid >> 6);
    const int G = gridDim.x, bx = blockIdx.x;
    const int vcu = (G % 8 == 0) ? (bx % 8) * (G / 8) + bx / 8 : bx;
    unsigned char* ws = a.ws;
    gu32* ctl = (gu32*)(ws + WS_CTL);
    if (tid < 64) MISC[tid] = 0u;
    __syncthreads();
#if MK_PER_PHASE
#define GRID_BAR() do {} while (0)
#else
    XcdBarrier bar = xcd_barrier_post((unsigned*)ctl + CW_BAR, MISC);
#define GRID_BAR() xcd_barrier(bar)
#endif
    const int lo = a.ph_lo, hi = a.ph_hi;
#define IN(k) (lo <= (k) && (k) < hi)
#define SEAM(k) do { if (IN(k) && IN((k) + 1)) { GRID_BAR(); if (PROBE & 64) { GRID_BAR(); GRID_BAR(); GRID_BAR(); GRID_BAR(); } } } while (0)
    const int gw = vcu * 8 + wave, NGW = G * 8;
    bf16_t* W1t = (bf16_t*)(ws + WS_W1); bf16_t* Wqb = (bf16_t*)(ws + WS_WQB); bf16_t* Wkvb = (bf16_t*)(ws + WS_WKVB);
    bf16_t* Wout = (bf16_t*)(ws + WS_WOUT); bf16_t* Wpg = (bf16_t*)(ws + WS_WPG); bf16_t* Wpe = (bf16_t*)(ws + WS_WPE);
    f32x2* ropeT = (f32x2*)(ws + WS_ROPET); f32x2* rowT = (f32x2*)(ws + WS_ROWT); f32x2* colT = (f32x2*)(ws + WS_COLT);
    float* S1 = (float*)(ws + WS_S1); float* S2 = (float*)(ws + WS_S2); float* SQ = (float*)(ws + WS_SQ); float* SKV = (float*)(ws + WS_SKV);
    bf16_t* PB = (bf16_t*)(ws + WS_PB); bf16_t* XB0 = (bf16_t*)(ws + WS_XB0); bf16_t* XB1 = (bf16_t*)(ws + WS_XB1);
    bf16_t* PROJ = (bf16_t*)(ws + WS_PROJ); bf16_t* QB = (bf16_t*)(ws + WS_Q); bf16_t* KVB = (bf16_t*)(ws + WS_KV); bf16_t* PE = (bf16_t*)(ws + WS_PE);

    if (IN(0)) for (int rep_ = 0; rep_ < ((PROBE & 16) ? 2 : 1); ++rep_) {
        const int tid = opaque_tid(), lane = tid & 63;
        LAS float* scr = (LAS float*)(lds + wave * 16384);
        constexpr int I_W1 = 32 * (LDP / 32), I_QB = 8 * (LDQ / 32), I_KVB = 4 * (LDKV / 32), I_SQ = 32 * 64, I_PE = 4 * 64;
        constexpr int I_L = I_W1 + I_QB + I_KVB + 2 * I_SQ + I_PE;
        for (int it = gw; it < 2 * I_L; it += NGW) {
            const int l = it / I_L; int r = it % I_L;
            if (r < I_W1) { const int nb = r % (LDP / 32), kb = r / (LDP / 32), n0 = nb * 32;
                tr_item(a.w_in + (size_t)l * DM * IN_COLS, IN_COLS, n0 < IN_COLS ? proj_src_col(n0) : 0, a.norm_g + l * DM, W1t + (size_t)l * LDP * DM, DM, kb * 64, n0, n0 >= IN_COLS, scr, lane, n0 < C_MLAG ? 0.125f * att::LOG2E : 1.0f, true); continue; }
            r -= I_W1;
            if (r < I_QB) { const int nb = r % (LDQ / 32), kb = r / (LDQ / 32), n0 = nb * 32;
                tr_item(a.w_q_b + (size_t)l * 512 * 1152, 1152, n0 < 1152 ? n0 : 0, a.q_a_norm + l * 512, Wqb + (size_t)l * LDQ * 512, 512, kb * 64, n0, n0 >= 1152, scr, lane); continue; }
            r -= I_QB;
            if (r < I_KVB) { const int nb = r % (LDKV / 32), kb = r / (LDKV / 32), n0 = nb * 32;
                tr_item(a.w_kv_b + (size_t)l * 256 * 1536, 1536, n0, a.kv_a_norm + l * 256, Wkvb + (size_t)l * LDKV * 256, 256, kb * 64, n0, false, scr, lane); continue; }
            r -= I_KVB;
            if (r < I_SQ) { const int nb = r % 64, kb = r / 64;
                tr_item(a.w_out + (size_t)l * DM * DM, DM, nb * 32, nullptr, Wout + (size_t)l * DM * DM, DM, kb * 64, nb * 32, false, scr, lane); continue; }
            r -= I_SQ;
            if (r < I_SQ) { const int nb = r % 64, kb = r / 64;
                tr_item(a.w_pg + (size_t)l * DM * DM, DM, nb * 32, a.ple_norm + l * DM, Wpg + (size_t)l * DM * DM, DM, kb * 64, nb * 32, false, scr, lane, 1.0f, true); continue; }
            r -= I_SQ;
            { const int nb = r % 64, kb = r / 64;
                tr_item(a.w_pe + (size_t)l * PLE * DM, DM, nb * 32, nullptr, Wpe + (size_t)l * DM * PLE, PLE, kb * 64, nb * 32, false, scr, lane); }
        }
        const double RB = 0.7498942093324558273;
        for (int i = (vcu * 512 + tid); i < SEQ_P * 32 + 256 * 16 + 64 * 16; i += G * 512) {
            int pos, j; double base; f32x2* dst;
            if (i < SEQ_P * 32) { pos = i >> 5; j = i & 31; base = RB; dst = ropeT + i; }
            else if (i < SEQ_P * 32 + 256 * 16) { const int k = i - SEQ_P * 32; pos = k >> 4; j = k & 15; base = RB * RB; dst = rowT + k; }
            else { const int k = i - SEQ_P * 32 - 256 * 16; pos = k >> 4; j = k & 15; base = RB * RB; dst = colT + k; }
            double inv = 1.0; for (int q = 0; q < j; ++q) inv *= base;
            float c_, s_; sincos_d((double)pos * inv, c_, s_);
            *dst = (f32x2){c_, s_};
        }
    }

    for (int g = 0; g < 2; ++g) {
        const int row_off = g ? GROWS0 : 0, grows = g ? GROWS1 : GROWS0, nM = grows / 256;
        const int pbase = 1 + g * 11;
        if (IN(pbase)) for (int rep_ = 0; rep_ < ((PROBE & 16) ? 2 : 1); ++rep_) {
            const int tid = opaque_tid(), lane = tid & 63; (void)tid;
            for (int r = gw; r < grows; r += NGW) {
                const f32x4* xr = (const f32x4*)x_row(a, row_off + r) + lane;
                f32x4 v[8]; float s = 0.f;
#pragma unroll
                for (int j = 0; j < 8; ++j) { v[j] = xr[64 * j]; s += (v[j][0] * v[j][0] + v[j][1] * v[j][1]) + (v[j][2] * v[j][2] + v[j][3] * v[j][3]); }
                s = wave_sum(s, lane);
                u32x2* o8 = (u32x2*)(XB0 + (size_t)r * DM) + lane;
#pragma unroll
                for (int j = 0; j < 8; ++j) o8[64 * j] = (u32x2){cvt_pk_f16(v[j][0], v[j][1]), cvt_pk_f16(v[j][2], v[j][3])};
                if (lane < 32) S1[(size_t)r * 32 + lane] = (lane == 0) ? s : 0.f;
            }
            for (int it = gw; it < 2 * grows; it += NGW) {
                const int l = it / grows, r = it % grows, grow = row_off + r;
                const float* pr = grow < SEQ_P ? a.pp + ((size_t)l * SEQ_P + grow) * PLE : a.ps + ((size_t)l * (NTOK - SEQ_P) + (grow - SEQ_P)) * PLE;
                const f32x4 v = ((const f32x4*)pr)[lane];
                ((u32x2*)(PB + ((size_t)l * GMAX + r) * PLE))[lane] = (u32x2){cvt_pk_bf16(v[0], v[1]), cvt_pk_bf16(v[2], v[3])};
            }
        }
        SEAM(pbase);
        for (int l = 0; l < 2; ++l) {
            const int ph = pbase + 1 + l * 5;
            bf16_t* XBa = (l == 0) ? XB0 : XB1; bf16_t* XBb = (l == 0) ? XB1 : XB0;
            if (IN(ph)) {
                pg8::Gemm gm{XBa, W1t + (size_t)l * LDP * DM};
                pg8::StaticOrder S; S.init(nM, LDP / 256, G, bx, WGM_P1);
                pg8::EpiBf16<true, true> E{PROJ, LDP, pg8::RowScale{S1, 32, 1.0f / DM}, SQ, SKV, TILE_CQ0, 1.0f};
                pg8::gemm_phase<DM, DM, decltype(E), true>(lds, gm, S, E);
                if (PROBE & 1) pg8::gemm_phase<DM, DM, decltype(E), true>(lds, gm, S, E);
            }
            SEAM(ph);
            if (IN(ph + 1)) {
                const int tid = opaque_tid(), lane = tid & 63; (void)tid;
                const float* gk = a.gk_norm + l * 64;
                for (int it = gw; it < grows / 2; it += NGW) {
                    const int r = it * 2 + (lane >> 5), hd = (lane >> 3) & 3, sub = lane & 7;
                    const int grow = row_off + r; const int t = grow < SEQ_P ? grow : (grow - SEQ_P) & (SEQ_S - 1);
                    bf16_t* p = PROJ + (size_t)r * LDP + C_GK + hd * 64 + sub * 8;
                    const bf16x8 v = *(const bf16x8*)p; float x[8], y[8]; float ss = 0.f;
#pragma unroll
                    for (int i = 0; i < 8; ++i) { x[i] = bf2f(v[i]); ss += x[i] * x[i]; }
                    ss += shx(ss, 1, lane); ss += shx(ss, 2, lane); ss += shx(ss, 4, lane);
                    const float rstd = 1.0f / sqrtf(ss * (1.0f / 64.0f) + EPS);
#pragma unroll
                    for (int i = 0; i < 8; ++i) x[i] *= rstd * gk[sub * 8 + i];
                    const f32x2* tb = (sub < 4 ? rowT + (t >> 6) * 16 : colT + (t & 63) * 16) + (sub & 1) * 8;
                    const bool second = (sub & 2) != 0;
#pragma unroll
                    for (int i = 0; i < 8; ++i) { const float o_ = shx(x[i], 2, lane); const f32x2 cs = tb[i]; y[i] = second ? x[i] * cs.x + o_ * cs.y : x[i] * cs.x - o_ * cs.y; }
                    *(u32x4*)p = (u32x4){cvt_pk_bf16(y[0], y[1]), cvt_pk_bf16(y[2], y[3]), cvt_pk_bf16(y[4], y[5]), cvt_pk_bf16(y[6], y[7])};
                    { int w0 = 0, w1 = 0;
                      w0 = __builtin_amdgcn_cvt_pk_fp8_f32(y[0], y[1], w0, false); w0 = __builtin_amdgcn_cvt_pk_fp8_f32(y[2], y[3], w0, true);
                      w1 = __builtin_amdgcn_cvt_pk_fp8_f32(y[4], y[5], w1, false); w1 = __builtin_amdgcn_cvt_pk_fp8_f32(y[6], y[7], w1, true);
                      *(u32x2*)(ws + WS_KF8 + (((size_t)(r >> 6) * 4 + hd) * 4 + (sub >> 1)) * 1024 + (r & 63) * 16 + 8 * (sub & 1)) = (u32x2){(unsigned)w0, (unsigned)w1}; }
                }
                for (int it = gw; it < (grows >> 6) * 4; it += NGW) {
                    const int T = it >> 2, hd = it & 3; const int slot = att::g8_slot(lane);
                    const bf16_t* vr = PROJ + ((size_t)T * 64 + lane) * LDP + C_GV + hd * 64;
                    LAS unsigned char* vo = lds + wave * 4096 + (slot & 15);
                    bf16x8 vv[8];
#pragma unroll
                    for (int cg = 0; cg < 8; ++cg) vv[cg] = *(const bf16x8*)(vr + cg * 8);
#pragma unroll
                    for (int cg = 0; cg < 8; ++cg) {
                        int w0 = 0, w1 = 0;
                        w0 = __builtin_amdgcn_cvt_pk_fp8_f32(bf2f(vv[cg][0]), bf2f(vv[cg][1]), w0, false); w0 = __builtin_amdgcn_cvt_pk_fp8_f32(bf2f(vv[cg][2]), bf2f(vv[cg][3]), w0, true);
                        w1 = __builtin_amdgcn_cvt_pk_fp8_f32(bf2f(vv[cg][4]), bf2f(vv[cg][5]), w1, false); w1 = __builtin_amdgcn_cvt_pk_fp8_f32(bf2f(vv[cg][6]), bf2f(vv[cg][7]), w1, true);
#pragma unroll
                        for (int e = 0; e < 8; ++e) { const int col = cg * 8 + e; const unsigned wv = e < 4 ? (unsigned)w0 : (unsigned)w1;
                            vo[col * 64 + ((((slot >> 4) ^ ((col >> 2) & 3))) << 4)] = (unsigned char)(wv >> (8 * (e & 3))); }
                    }
                    asm volatile("s_waitcnt lgkmcnt(0)" ::: "memory");
                    { const LAS unsigned char* li = lds + wave * 4096 + lane * 16; unsigned char* go = ws + WS_GV8 + (size_t)it * 4096 + lane * 16;
#pragma unroll
                      for (int p = 0; p < 4; ++p) *(u32x4*)(go + p * 1024) = *(const LAS u32x4*)(li + p * 1024); }
                    asm volatile("s_waitcnt lgkmcnt(0)" ::: "memory");
                }
                for (int it = gw; it < grows / 8; it += NGW) {
                    const int r = it * 8 + (lane >> 3), sub = lane & 7;
                    const int grow = row_off + r; const int t = grow < SEQ_P ? grow : (grow - SEQ_P) & (SEQ_S - 1);
                    bf16_t* p = PROJ + (size_t)r * LDP + C_KR + sub * 8;
                    const bf16x8 v = *(const bf16x8*)p; float x[8], y[8];
#pragma unroll
                    for (int i = 0; i < 8; ++i) x[i] = bf2f(v[i]);
                    const f32x2* tb = ropeT + (size_t)t * 32 + (sub & 3) * 8; const bool second = (sub & 4) != 0;
#pragma unroll
                    for (int i = 0; i < 8; ++i) { const float o_ = shx(x[i], 4, lane); const f32x2 cs = tb[i]; y[i] = second ? x[i] * cs.x + o_ * cs.y : x[i] * cs.x - o_ * cs.y; }
                    *(u32x4*)p = (u32x4){cvt_pk_bf16(y[0], y[1]), cvt_pk_bf16(y[2], y[3]), cvt_pk_bf16(y[4], y[5]), cvt_pk_bf16(y[6], y[7])};
                    { int w0 = 0, w1 = 0;
                      w0 = __builtin_amdgcn_cvt_pk_fp8_f32(y[0], y[1], w0, false); w0 = __builtin_amdgcn_cvt_pk_fp8_f32(y[2], y[3], w0, true);
                      w1 = __builtin_amdgcn_cvt_pk_fp8_f32(y[4], y[5], w1, false); w1 = __builtin_amdgcn_cvt_pk_fp8_f32(y[6], y[7], w1, true);
                      const int d0_ = sub * 8; const int pos = 32 * ((d0_ & 31) >> 4) + 16 * (d0_ >> 5) + (d0_ & 15);
                      *(u32x2*)(ws + WS_KR8 + ((size_t)(r >> 6) * 4 + (pos >> 4)) * 1024 + (r & 63) * 16 + (pos & 15)) = (u32x2){(unsigned)w0, (unsigned)w1}; }
                }
                VM_WAIT(); __syncthreads();
                { pg8::Gemm gm{PROJ + C_CQ, Wqb + (size_t)l * LDQ * 512};
                  pg8::StaticOrder S; S.init(nM, LDQ / 256, G, bx, WGM_SM);
                  pg8::EpiBf16<true, false> E{QB, LDQ, pg8::RowScale{SQ, 8, 1.0f / 512}, nullptr, nullptr, 0, att::Cfg<0>::SCALE * att::LOG2E};
                  pg8::gemm_phase<LDP, 512>(lds, gm, S, E); if (PROBE & 1) pg8::gemm_phase<LDP, 512>(lds, gm, S, E); }
                { pg8::Gemm gm{PROJ + C_CKV, Wkvb + (size_t)l * LDKV * 256};
                  pg8::StaticOrder S; S.init(nM, LDKV / 256, G, bx, WGM_SM);
                  pg8::EpiKV8 E{ws + WS_KN8, ws + WS_V8, pg8::RowScale{SKV, 4, 1.0f / 256}};
                  pg8::gemm_phase<LDP, 256, decltype(E), false, true>(lds, gm, S, E); if (PROBE & 1) pg8::gemm_phase<LDP, 256, decltype(E), false, true>(lds, gm, S, E); }
            }
            SEAM(ph + 1);
            if (IN(ph + 2)) {
                const int tid = opaque_tid();
                att::Ctx cx{PROJ, QB, KVB, (const unsigned char*)(ws + WS_KF8), (const unsigned char*)(ws + WS_GV8), (const unsigned char*)(ws + WS_KN8), (const unsigned char*)(ws + WS_V8), (const unsigned char*)(ws + WS_KR8), ropeT, rowT, colT, a.gq_norm + l * 64, a.gk_norm + l * 64, a.na_rpb + (size_t)l * 8 * 15 * 31};
                bool gq_ok;
                { const int ln = tid & 63; float gqm = fabsf(cx.gq_norm[ln]), gkm = fabsf(cx.gk_norm[ln]);
#pragma unroll
                  for (int o_ = 1; o_ < 16; o_ <<= 1) { gqm = fmaxf(gqm, shx(gqm, o_, ln)); gkm = fmaxf(gkm, shx(gkm, o_, ln)); }
                  gqm = fmaxf(gqm, part16(gqm)); gkm = fmaxf(gkm, part16(gkm)); gqm = fmaxf(gqm, part32(gqm)); gkm = fmaxf(gkm, part32(gkm));
                  const float Mb = 64.0f * gqm * gkm * 0.125f * att::LOG2E;
                  gq_ok = __builtin_amdgcn_readfirstlane((int)(Mb <= 15.0f)) != 0; }
                gu32* qh = ctl + CW_QUEUE + 64 * ((g * 2 + l) * 3);
#define ATT_LOOP(KIND, REPS) do { constexpr int H_ = (KIND == 1) ? 4 : att::Cfg<KIND>::H; const int total = (g == 0 ? 128 : 64) * H_; \
                for (int rep = 0; rep < (REPS); ++rep) { const bool dry = rep + 1 < (REPS); \
                for (;;) { if (tid == 0) MISC[4] = __hip_atomic_fetch_add(qh + 64 * (KIND + 12 * rep), 1u, __ATOMIC_RELAXED, __HIP_MEMORY_SCOPE_AGENT); \
                    __syncthreads(); const int idx = __builtin_amdgcn_readfirstlane((int)MISC[4]); __syncthreads(); \
                    if (idx >= total) break; \
                    int s0, slen, hh, qb; \
                    if (g == 0 && idx < 64 * H_) { s0 = 0; slen = SEQ_P; hh = idx >> 6; qb = idx & 63; } \
                    else { const int k = (g == 0) ? idx - 64 * H_ : idx; const int sq = k / (8 * H_), rem = k % (8 * H_); s0 = (g == 0 ? SEQ_P : 0) + sq * SEQ_S; slen = SEQ_S; hh = rem >> 3; qb = rem & 7; } \
                    if (KIND == 1) { if (gq_ok) att::gqa9_unit(cx, s0, slen, hh, qb, lds, dry); else { for (int h3 = 0; h3 < 3; ++h3) att::attn_unit<1>(cx, s0, slen, hh * 3 + h3, qb, lds, dry); } } \
                    else if (KIND == 2) att::na_unit(cx, s0, slen, hh, qb, lds, dry); else att::mla9_unit(cx, s0, slen, hh, qb, lds, dry); } } } while (0)
                ATT_LOOP(0, (PROBE & 2) ? 2 : 1);
                ATT_LOOP(1, (PROBE & 4) ? 2 : 1);
                ATT_LOOP(2, (PROBE & 8) ? 2 : 1);
#undef ATT_LOOP
            }
            SEAM(ph + 2);
            if (IN(ph + 3)) {
                { pg8::Gemm gm{PROJ, Wout + (size_t)l * DM * DM};
                  pg8::StaticOrder S; S.init(nM, DM / 256, G, bx, WGM_SQ);
                  pg8::EpiRes1 E{XBa, S2};
                  pg8::gemm_phase<LDP, DM>(lds, gm, S, E); }
                { pg8::Gemm gm{PB + (size_t)l * GMAX * PLE, Wpe + (size_t)l * DM * PLE};
                  pg8::StaticOrder S; S.init(nM, DM / 256, G, bx, WGM_SQ);
                  pg8::EpiBf16<false, false> E{PE, DM, pg8::RowScale{nullptr, 0, 0.f}, nullptr, nullptr, 0, 1.0f};
                  pg8::gemm_phase<PLE, PLE>(lds, gm, S, E); if (PROBE & 1) pg8::gemm_phase<PLE, PLE>(lds, gm, S, E); }
            }
            SEAM(ph + 3);
            if (IN(ph + 4)) {
                pg8::Gemm gm{XBa, Wpg + (size_t)l * DM * DM};
                pg8::StaticOrder S; S.init(nM, DM / 256, G, bx, WGM_SQ);
                pg8::EpiGate E{XBa, PE, XBb, S1, pg8::RowScale{S2, 32, 1.0f / DM}};
                pg8::gemm_phase<DM, DM, decltype(E), true>(lds, gm, S, E);
            }
            SEAM(ph + 4);
        }
        const int pf = (g == 0) ? 12 : 23;
        if (IN(pf)) {
            const int tid = opaque_tid(), lane = tid & 63; (void)tid;
            for (int r = gw; r < grows; r += NGW) {
                const f32x4 sv = ((const f32x4*)(S1 + (size_t)r * 32))[lane & 7];
                float s = (sv[0] + sv[1]) + (sv[2] + sv[3]); s += shx(s, 1, lane); s += shx(s, 2, lane); s += shx(s, 4, lane);
                const float rstd = 1.0f / sqrtf(s * (1.0f / DM) + EPS);
                f32x4* orow = (f32x4*)(a.out + (size_t)(row_off + r) * DM) + lane; const f32x4* fg = (const f32x4*)a.final_norm + lane;
                const u32x2* xr = (const u32x2*)(XB0 + (size_t)r * DM) + lane;
                u32x2 xv[8];
#pragma unroll
                for (int j = 0; j < 8; ++j) xv[j] = xr[64 * j];
#pragma unroll
                for (int j = 0; j < 8; ++j) { const f32x4 v = {h_lo(xv[j].x), h_hi(xv[j].x), h_lo(xv[j].y), h_hi(xv[j].y)}, gg = fg[64 * j]; orow[64 * j] = v * rstd * gg; }
            }
            if (g == 0) { VM_WAIT(); __syncthreads(); }
        }
    }
#undef IN
#undef SEAM
#undef GRID_BAR
}

extern "C" void kernel_launch(void* const* d_in, const int* in_sizes, int n_in, void* d_out, int out_size, void* d_ws, size_t ws_size, hipStream_t stream) {
    static int grid = 0;
    if (grid == 0) {
        if (n_in != 18 || out_size != NTOK * DM || ws_size < WS_END) { fprintf(stderr, "kernel_launch: shape mismatch (n_in %d, out %d, ws %zu < %zu)\n", n_in, out_size, ws_size, (size_t)WS_END); grid = -1; return; }
        int dev = 0, cus = 0;
        if (hipGetDevice(&dev) != hipSuccess || hipDeviceGetAttribute(&cus, hipDeviceAttributeMultiprocessorCount, dev) != hipSuccess) { grid = -1; return; }
        if (hipFuncSetAttribute((const void*)fwd, hipFuncAttributeMaxDynamicSharedMemorySize, LDS_BYTES) != hipSuccess) { fprintf(stderr, "kernel_launch: hipFuncSetAttribute failed\n"); grid = -1; return; }
        int per_cu = 0;
        if (hipOccupancyMaxActiveBlocksPerMultiprocessor(&per_cu, (const void*)fwd, 512, LDS_BYTES) != hipSuccess || per_cu < 1) fprintf(stderr, "kernel_launch: occupancy query reports %d\n", per_cu);
        (void)hipGetLastError();
        grid = cus;
    }
    if (grid < 0) return;
    if (hipMemsetAsync((char*)d_ws + WS_CTL, 0, CTL_ZERO_BYTES, stream) != hipSuccess) return;
    Args a{};
    a.xp = (const float*)d_in[0]; a.xs = (const float*)d_in[1]; a.pp = (const float*)d_in[2]; a.ps = (const float*)d_in[3]; a.norm_g = (const float*)d_in[4]; a.w_in = (const float*)d_in[5];
    a.na_rpb = (const float*)d_in[6]; a.q_a_norm = (const float*)d_in[7]; a.w_q_b = (const float*)d_in[8]; a.kv_a_norm = (const float*)d_in[9]; a.w_kv_b = (const float*)d_in[10];
    a.gq_norm = (const float*)d_in[11]; a.gk_norm = (const float*)d_in[12]; a.w_out = (const float*)d_in[13]; a.ple_norm = (const float*)d_in[14]; a.w_pe = (const float*)d_in[15];
    a.w_pg = (const float*)d_in[16]; a.final_norm = (const float*)d_in[17];
    a.out = (float*)d_out; a.ws = (unsigned char*)d_ws;
#if MK_PER_PHASE
    for (int p = 0; p < NPHASE; ++p) { a.ph_lo = p; a.ph_hi = p + 1; hipLaunchKernelGGL(fwd, dim3(grid), dim3(512), LDS_BYTES, stream, a); }
#else
    a.ph_lo = 0; a.ph_hi = NPHASE; hipLaunchKernelGGL(fwd, dim3(grid), dim3(512), LDS_BYTES, stream, a);
#endif
    const hipError_t le = hipPeekAtLastError();
    if (le != hipSuccess) fprintf(stderr, "kernel_launch: launch failed: %s\n", hipGetErrorName(le));
}
```

```cpp
#include <hip/hip_runtime.h>
#include <cstdio>
#include <cstdint>

#ifndef MK_PER_PHASE
#define MK_PER_PHASE 0
#endif

#ifndef WGM_P1
#define WGM_P1 8
#endif
#ifndef WGM_SQ
#define WGM_SQ 2
#endif
#ifndef WGM_SM
#define WGM_SM 4
#endif
#ifndef PROBE
#define PROBE 0
#endif
#define LAS __attribute__((address_space(3)))
#define GAS __attribute__((address_space(1)))
typedef unsigned short bf16_t;
typedef short bf16x8 __attribute__((ext_vector_type(8)));
typedef short s16x4 __attribute__((ext_vector_type(4)));
typedef float f32x2 __attribute__((ext_vector_type(2)));
typedef float f32x4 __attribute__((ext_vector_type(4)));
typedef float f32x16 __attribute__((ext_vector_type(16)));
typedef unsigned u32x2 __attribute__((ext_vector_type(2)));
typedef unsigned u32x4 __attribute__((ext_vector_type(4)));
typedef GAS unsigned gu32;

constexpr int DM = 2048, NTOK = 49152, SEQ_P = 16384, SEQ_S = 2048, PLE = 256;
constexpr int IN_COLS = 5696, LDP = 5888;
constexpr int GROWS0 = 32768, GROWS1 = 16384, GMAX = 32768;
constexpr float EPS = 1e-6f;
constexpr int C_NAQ = 0, C_MLAG = 512, C_GQ = 1280, C_NAK = 2048, C_NAV = 2560, C_NAG = 3072, C_CQ = 3584, C_CKV = 4096, C_GK = 4352, C_GV = 4608, C_GQG = 4864, C_KR = 5632;
constexpr int LDQ = 1280, LDKV = 1536;
constexpr int TILE_CQ0 = C_CQ / 256, TILE_CKV = C_CKV / 256;

constexpr size_t MiB = 1u << 20;
constexpr size_t WS_CTL = 0, CTL_ZERO_BYTES = 1 * MiB;
constexpr size_t SZ_W1 = (size_t)LDP * DM * 2, SZ_WQB = (size_t)LDQ * 512 * 2, SZ_WKVB = (size_t)LDKV * 256 * 2, SZ_WSQ = (size_t)DM * DM * 2, SZ_WPE = (size_t)DM * PLE * 2;
constexpr size_t WS_W1 = 1 * MiB;
constexpr size_t WS_WQB = WS_W1 + 2 * SZ_W1;
constexpr size_t WS_WKVB = WS_WQB + 2 * SZ_WQB;
constexpr size_t WS_WOUT = WS_WKVB + 2 * SZ_WKVB;
constexpr size_t WS_WPG = WS_WOUT + 2 * SZ_WSQ;
constexpr size_t WS_WPE = WS_WPG + 2 * SZ_WSQ;
constexpr size_t WS_ROPET = WS_WPE + 2 * SZ_WPE;
constexpr size_t WS_ROWT = WS_ROPET + (size_t)SEQ_P * 32 * 8;
constexpr size_t WS_COLT = WS_ROWT + 256 * 16 * 8;
constexpr size_t WS_S1 = ((WS_COLT + 64 * 16 * 8 + 4095) / 4096) * 4096;
constexpr size_t WS_S2 = WS_S1 + (size_t)GMAX * 32 * 4;
constexpr size_t WS_SQ = WS_S2 + (size_t)GMAX * 32 * 4;
constexpr size_t WS_SKV = WS_SQ + (size_t)GMAX * 8 * 4;
constexpr size_t WS_PB = WS_SKV + (size_t)GMAX * 4 * 4;
constexpr size_t WS_XB0 = WS_PB + (size_t)2 * GMAX * PLE * 2;
constexpr size_t WS_XB1 = WS_XB0 + (size_t)GMAX * DM * 2;
constexpr size_t WS_PROJ = WS_XB1 + (size_t)GMAX * DM * 2;
constexpr size_t WS_Q = WS_PROJ + (size_t)GMAX * LDP * 2;
constexpr size_t WS_KV = WS_Q + (size_t)GMAX * LDQ * 2;
constexpr size_t WS_PE = WS_Q;
constexpr size_t WS_KN8 = WS_KV;
constexpr size_t WS_V8 = WS_KN8 + (size_t)GMAX * 768;
constexpr size_t WS_KR8 = WS_V8 + (size_t)GMAX * 768;
static_assert(WS_KR8 + (size_t)GMAX * 64 <= WS_KV + (size_t)GMAX * LDKV * 2, "fp8 MLA operands fit the KV region");
constexpr size_t WS_KF8 = WS_KV + (size_t)GMAX * LDKV * 2;
constexpr size_t WS_GV8 = WS_KF8 + (size_t)GMAX * 256;
constexpr size_t WS_END = WS_GV8 + (size_t)GMAX * 256;
static_assert(WS_PE + (size_t)GMAX * DM * 2 <= WS_END, "PE overlay fits Q|KV");
static_assert(WS_END <= (size_t)1024 * MiB, "workspace map fits 1 GiB");
constexpr int CW_BAR = 4096;
constexpr int CW_QUEUE = 16384;

constexpr int RING_BYTES = 131072;
constexpr int TBL_OFF = RING_BYTES;
constexpr int MISC_OFF = TBL_OFF + 4096;
constexpr int LDS_BYTES = MISC_OFF + 256;
constexpr int A_KOFF = 0, A_KMAX = 24 * 1040;
constexpr int A_VOFF = 2 * 25088, A_VMAX = 16384;
constexpr int A_WSOFF = A_VOFF + 2 * A_VMAX;
constexpr int A_BOFF = A_WSOFF + 2048;
constexpr int A_QROFF = A_BOFF + 2048;
static_assert(A_KMAX <= 25088 && A_QROFF + 8 * 4096 <= RING_BYTES, "attention LDS map");

__device__ __forceinline__ unsigned cvt_pk_bf16(float lo, float hi) { unsigned r; asm volatile("v_cvt_pk_bf16_f32 %0, %1, %2" : "=v"(r) : "v"(lo), "v"(hi)); return r; }
typedef _Float16 f16x2 __attribute__((ext_vector_type(2)));
typedef _Float16 f16x8 __attribute__((ext_vector_type(8)));
__device__ __forceinline__ unsigned cvt_pk_f16(float lo, float hi) { const f16x2 v = {(_Float16)lo, (_Float16)hi}; return __builtin_bit_cast(unsigned, v); }
__device__ __forceinline__ float h_lo(unsigned w) { return (float)__builtin_bit_cast(f16x2, w)[0]; }
__device__ __forceinline__ float h_hi(unsigned w) { return (float)__builtin_bit_cast(f16x2, w)[1]; }
__device__ __forceinline__ float bf_lo(unsigned w) { return __uint_as_float(w << 16); }
__device__ __forceinline__ float bf_hi(unsigned w) { return __uint_as_float(w & 0xffff0000u); }
__device__ __forceinline__ float bf2f(short s) { return __uint_as_float(((unsigned)(unsigned short)s) << 16); }
#define LDS_WAIT() asm volatile("s_waitcnt lgkmcnt(0)" ::: "memory")
#define VM_WAIT() asm volatile("s_waitcnt vmcnt(0)" ::: "memory")
#define SBAR() __builtin_amdgcn_sched_barrier(0)
__device__ __forceinline__ int opaque_tid() { int t = threadIdx.x; asm volatile("" : "+v"(t)); return t; }
__device__ __forceinline__ float part32(float v) { const unsigned u = __float_as_uint(v); auto rr = __builtin_amdgcn_permlane32_swap(u, u, false, false); return __uint_as_float(rr[0] ^ rr[1] ^ u); }
__device__ __forceinline__ float part16(float v) { const unsigned u = __float_as_uint(v); auto rr = __builtin_amdgcn_permlane16_swap(u, u, false, false); return __uint_as_float(rr[0] ^ rr[1] ^ u); }
__device__ __forceinline__ float shx(float v, int mask, int lane) { return __int_as_float(__builtin_amdgcn_ds_bpermute((lane ^ mask) << 2, __float_as_int(v))); }
__device__ __forceinline__ float wave_sum(float v, int lane) {
    v += shx(v, 1, lane); v += shx(v, 2, lane); v += shx(v, 4, lane); v += shx(v, 8, lane); v += part16(v); v += part32(v);
    return v;
}

namespace pg8 {
constexpr int BM = 256, BK = 64, HALF = 128, HTB = HALF * BK * 2, NXCD = 8, WGM = 8;
__host__ __device__ __forceinline__ int lds_byte(int r, int c) { const int st = (r >> 4) * 2 + (c >> 5), rr = r & 15, cc = c & 31, ob = rr * 64 + cc * 2; return st * 1024 + (ob ^ (((ob >> 9) & 1) << 5)); }
__host__ __device__ __forceinline__ void stage_rc(int b, int& R, int& C) { const int st = b / 1024, sb = b % 1024, swz = sb ^ (((sb >> 9) & 1) << 5); R = (st >> 1) * 16 + swz / 64; C = (st & 1) * 32 + (swz % 64) / 2; }
__host__ __device__ __forceinline__ int perm32(int rho) { const int n = rho >> 4, i = rho & 15; return 8 * (i >> 2) + 4 * n + (i & 3); }

struct Unit { int pm, pn; };
struct Gemm { const bf16_t* A; const bf16_t* Bt; };

struct StaticOrder {
    int nM, nN, nwg, G, c, wgm;
    __device__ __forceinline__ void init(int nM_, int nN_, int G_, int c_, int wgm_ = WGM) { nM = nM_; nN = nN_; nwg = nM * nN; G = G_; c = c_; wgm = wgm_; }
    __device__ __forceinline__ bool next(int i, Unit& u) const {
        const long L = (long)i * G + c; if (L >= nwg) return false;
        int wgid = (int)L; { const int q = nwg / NXCD, r = nwg % NXCD, xcd = wgid % NXCD, off = wgid / NXCD; wgid = (xcd < r ? xcd * (q + 1) : r * (q + 1) + (xcd - r) * q) + off; }
        const int nig = wgm * nN, gid = wgid / nig, fm = gid * wgm, gsz = (nM - fm) < wgm ? (nM - fm) : wgm;
        u.pm = fm + ((wgid % nig) % gsz); u.pn = (wgid % nig) / gsz; return true;
    }
};

template <int LDA, int K, class Epi, bool F16 = false, bool TRB1 = false>
__device__ __forceinline__ void gemm_phase(LAS unsigned char* lds, const Gemm g, const StaticOrder& S, const Epi& E) {
    const int tid = opaque_tid(), wid = __builtin_amdgcn_readfirstlane(tid >> 6), lane = tid & 63, wr = wid >> 2, wc = wid & 3, fr = lane & 15, fq = lane >> 4;
    constexpr int nt = K / BK;
    unsigned voffA[2], voffB[2];
#pragma unroll
    for (int i = 0; i < 2; ++i) { int R, C; stage_rc(tid * 16 + i * 8192, R, C); const int Rb = (R & ~31) + perm32(R & 31);
        voffA[i] = (unsigned)(R * LDA + C) * 2u; voffB[i] = (unsigned)(Rb * K + C) * 2u; }
    constexpr size_t kstep = (size_t)(BK * 2);
    constexpr size_t hstepA = (size_t)HALF * LDA * 2, hstepB = (size_t)HALF * K * 2;
    constexpr size_t tstepA = 2 * hstepA, tstepB = 2 * hstepB;
    const unsigned ldsw = (unsigned)wid * 1024u;
    const int aoff = lds_byte(wr * 64 + fr, fq * 8), boff = lds_byte(wc * 32 + fr, fq * 8);
#define PG8_SA(b, h) (((b) * 2 + (h)) * HTB)
#define PG8_SB(b, h) ((4 + (b) * 2 + (h)) * HTB)
#define PG8_STAGE(bufoff, gbase, voff) do { _Pragma("unroll") for (int _i = 0; _i < 2; ++_i) \
        __builtin_amdgcn_global_load_lds((const unsigned*)((const char*)(gbase) + (voff)[_i]), (LAS unsigned*)(lds + (bufoff) + ldsw + _i * 8192), 16, 0, 0); } while (0)
#define PG8_LDA(dst, b, h) do { _Pragma("unroll") for (int m = 0; m < 4; ++m) _Pragma("unroll") for (int k = 0; k < 2; ++k) dst[m][k] = *(const LAS bf16x8*)(lds + PG8_SA(b, h) + aoff + m * 2048 + k * 1024); } while (0)
#define PG8_LDB(dst, b, h) do { _Pragma("unroll") for (int n = 0; n < 2; ++n) _Pragma("unroll") for (int k = 0; k < 2; ++k) dst[n][k] = *(const LAS bf16x8*)(lds + PG8_SB(b, h) + boff + n * 2048 + k * 1024); } while (0)
#define PG8_MMA(ai, bj, At, Bt) do { __builtin_amdgcn_s_setprio(1); _Pragma("unroll") for (int m = 0; m < 4; ++m) _Pragma("unroll") for (int n = 0; n < 2; ++n) _Pragma("unroll") for (int k = 0; k < 2; ++k) \
        acc[ai][bj][m][n] = F16 ? __builtin_amdgcn_mfma_f32_16x16x32_f16(__builtin_bit_cast(f16x8, Bt[n][k]), __builtin_bit_cast(f16x8, At[m][k]), acc[ai][bj][m][n], 0, 0, 0) \
                          : (TRB1 && (bj) == 1) ? __builtin_amdgcn_mfma_f32_16x16x32_bf16(At[m][k], Bt[n][k], acc[ai][bj][m][n], 0, 0, 0) \
                                : __builtin_amdgcn_mfma_f32_16x16x32_bf16(Bt[n][k], At[m][k], acc[ai][bj][m][n], 0, 0, 0); __builtin_amdgcn_s_setprio(0); } while (0)
#define PG8_WAIT_V(n) asm volatile("s_waitcnt vmcnt(" #n ")" ::: "memory")
#define PG8_WAIT_L(n) asm volatile("s_waitcnt lgkmcnt(" #n ")" ::: "memory")
#define PG8_BAR __builtin_amdgcn_s_barrier()
#define PG8_SCHED __builtin_amdgcn_sched_barrier(0)
    Unit cur, nxt; int ui = 0;
    if (!S.next(0, cur)) return;
    f32x4 acc[2][2][4][2];
#pragma unroll
    for (int a = 0; a < 2; ++a)
#pragma unroll
        for (int b = 0; b < 2; ++b)
#pragma unroll
            for (int m = 0; m < 4; ++m)
#pragma unroll
                for (int n = 0; n < 2; ++n) acc[a][b][m][n] = (f32x4){0.f, 0.f, 0.f, 0.f};
    bf16x8 At[4][2], B0[2][2], B1[2][2];
    const char* cA = (const char*)g.A + (size_t)cur.pm * tstepA; const char* cB = (const char*)g.Bt + (size_t)cur.pn * tstepB;
    E.prep(cur, 0, lds, tid);
    PG8_STAGE(PG8_SB(0, 0), cB, voffB); PG8_STAGE(PG8_SB(0, 1), cB + hstepB, voffB); PG8_STAGE(PG8_SA(0, 0), cA, voffA); PG8_STAGE(PG8_SA(0, 1), cA + hstepA, voffA);
    if (wr == 1) PG8_BAR;
    PG8_WAIT_V(2); PG8_BAR;
    PG8_STAGE(PG8_SB(1, 0), cB + kstep, voffB); PG8_STAGE(PG8_SA(1, 0), cA + kstep, voffA); PG8_STAGE(PG8_SB(1, 1), cB + hstepB + kstep, voffB);
    PG8_WAIT_V(6); PG8_BAR;
    for (;;) {
        const bool has_next = S.next(ui + 1, nxt);
        const char* nA = has_next ? (const char*)g.A + (size_t)nxt.pm * tstepA : cA; const char* nB = has_next ? (const char*)g.Bt + (size_t)nxt.pn * tstepB : cB;
#pragma nounroll
        for (int t = 0; t < nt; t += 2) {
            const bool last = (t == nt - 2);
            const char* a1 = cA + (size_t)(t + 1) * kstep;
            const char* a2 = last ? nA : cA + (size_t)(t + 2) * kstep; const char* b2 = last ? nB : cB + (size_t)(t + 2) * kstep;
            const char* a3 = a2 + kstep; const char* b3 = b2 + kstep;
            if (last && has_next) E.prep(nxt, ui + 1, lds, tid);
            PG8_LDB(B0, 0, 0); PG8_LDB(B1, 0, 1); PG8_SCHED; PG8_LDA(At, 0, 0); PG8_STAGE(PG8_SA(1, 1), a1 + hstepA, voffA);
            PG8_WAIT_V(8); PG8_WAIT_L(0); PG8_BAR; PG8_MMA(0, 0, At, B0); PG8_MMA(0, 1, At, B1); PG8_BAR; PG8_SCHED;
            PG8_LDA(At, 0, 1); PG8_STAGE(PG8_SB(0, 0), b2, voffB); PG8_STAGE(PG8_SB(0, 1), b2 + hstepB, voffB); PG8_STAGE(PG8_SA(0, 0), a2, voffA);
            PG8_WAIT_V(8); PG8_WAIT_L(0); PG8_BAR; PG8_MMA(1, 0, At, B0); PG8_MMA(1, 1, At, B1); PG8_BAR; PG8_SCHED;
            PG8_LDB(B0, 1, 0); PG8_LDB(B1, 1, 1); PG8_SCHED; PG8_LDA(At, 1, 0); PG8_STAGE(PG8_SA(0, 1), a2 + hstepA, voffA);
            PG8_WAIT_V(8); PG8_WAIT_L(0); PG8_BAR; PG8_MMA(0, 0, At, B0); PG8_MMA(0, 1, At, B1); PG8_BAR; PG8_SCHED;
            PG8_LDA(At, 1, 1); PG8_STAGE(PG8_SB(1, 0), b3, voffB); PG8_STAGE(PG8_SB(1, 1), b3 + hstepB, voffB); PG8_STAGE(PG8_SA(1, 0), a3, voffA);
            PG8_WAIT_V(8); PG8_WAIT_L(0); PG8_BAR; PG8_MMA(1, 0, At, B0); PG8_MMA(1, 1, At, B1); PG8_BAR; PG8_SCHED;
        }
        if (wr == 0) PG8_BAR;
        E(acc, cur, ui, wr, wc, fr, fq, lds);
        if (!has_next) break;
#pragma unroll
        for (int a = 0; a < 2; ++a)
#pragma unroll
            for (int b = 0; b < 2; ++b)
#pragma unroll
                for (int m = 0; m < 4; ++m)
#pragma unroll
                    for (int n = 0; n < 2; ++n) acc[a][b][m][n] = (f32x4){0.f, 0.f, 0.f, 0.f};
        cur = nxt; cA = nA; cB = nB; ++ui;
        if (wr == 1) PG8_BAR;
    }
    PG8_WAIT_V(0);
    PG8_BAR;
#undef PG8_SA
#undef PG8_SB
#undef PG8_STAGE
#undef PG8_LDA
#undef PG8_LDB
#undef PG8_MMA
#undef PG8_WAIT_V
#undef PG8_WAIT_L
#undef PG8_BAR
#undef PG8_SCHED
}

typedef f32x4 Acc[2][2][4][2];
struct RowScale {
    const float* slab; int npart; float inv_n;
    __device__ __forceinline__ void fill(LAS unsigned char* lds, int ui, int row0, int tid) const {
        if (tid < 256) {
            const float* p = slab + (size_t)(row0 + tid) * npart; float s = 0.f;
            for (int i = 0; i < npart; i += 4) { const f32x4 v = *(const f32x4*)(p + i); s += (v[0] + v[1]) + (v[2] + v[3]); }
            ((LAS float*)(lds + TBL_OFF))[(ui & 1) * 256 + tid] = 1.0f / sqrtf(s * inv_n + EPS);
        }
    }
    __device__ __forceinline__ float get(LAS unsigned char* lds, int ui, int rl) const { return ((const LAS float*)(lds + TBL_OFF))[(ui & 1) * 256 + rl]; }
};
__device__ __forceinline__ float quad_row_sum(float s) { s += part16(s); s += part32(s); return s; }
__device__ __forceinline__ float sq8(const f32x4& a, const f32x4& b) { return (a[0] * a[0] + a[1] * a[1]) + (a[2] * a[2] + a[3] * a[3]) + (b[0] * b[0] + b[1] * b[1]) + (b[2] * b[2] + b[3] * b[3]); }
__device__ __forceinline__ u32x4 pack8(const f32x4& a, const f32x4& b) { u32x4 w; w.x = cvt_pk_bf16(a[0], a[1]); w.y = cvt_pk_bf16(a[2], a[3]); w.z = cvt_pk_bf16(b[0], b[1]); w.w = cvt_pk_bf16(b[2], b[3]); return w; }

template <bool SCALE, bool STATS> struct EpiBf16 {
    bf16_t* O; int ldc; RowScale rs; float* sq; float* skv; int st0; float mul;
    __device__ __forceinline__ void prep(const Unit& u, int ui, LAS unsigned char* lds, int tid) const { if (SCALE) rs.fill(lds, ui, u.pm * BM, tid); }
    __device__ __forceinline__ void operator()(const Acc& acc, const Unit& u, int ui, int wr, int wc, int fr, int fq, LAS unsigned char* lds) const {
        const int col0 = u.pn * BM + wc * 32 + 8 * fq;
        const int st = STATS ? (u.pn - st0) : -1;
#pragma unroll
        for (int ai = 0; ai < 2; ++ai)
#pragma unroll
            for (int m = 0; m < 4; ++m) {
                const int rl = ai * HALF + wr * 64 + m * 16 + fr; const size_t row = (size_t)u.pm * BM + rl;
                const float s = SCALE ? rs.get(lds, ui, rl) * mul : 1.f;
                bf16_t* rowp = O + row * ldc + col0; float ss = 0.f;
#pragma unroll
                for (int bj = 0; bj < 2; ++bj) { const f32x4 v0 = acc[ai][bj][m][0] * s, v1 = acc[ai][bj][m][1] * s;
                    if (STATS) ss += sq8(v0, v1);
                    *(u32x4*)(rowp + bj * HALF) = pack8(v0, v1); }
                if (STATS) { if (st >= 0 && st < 3) { ss = quad_row_sum(ss); if (fq == 0) { if (st < 2) sq[row * 8 + st * 4 + wc] = ss; else skv[row * 4 + wc] = ss; } } }
            }
    }
};
__device__ __forceinline__ u32x4 pack8h(const f32x4& a, const f32x4& b) { u32x4 w; w.x = cvt_pk_f16(a[0], a[1]); w.y = cvt_pk_f16(a[2], a[3]); w.z = cvt_pk_f16(b[0], b[1]); w.w = cvt_pk_f16(b[2], b[3]); return w; }
struct EpiRes1 {
    bf16_t* xb; float* slab;
    __device__ __forceinline__ void prep(const Unit&, int, LAS unsigned char*, int) const {}
    __device__ __forceinline__ void operator()(const Acc& acc, const Unit& u, int ui, int wr, int wc, int fr, int fq, LAS unsigned char* lds) const {
        int fre = fr, fqe = fq; asm volatile("" : "+v"(fre), "+v"(fqe));
        bf16_t* xt = xb + (size_t)u.pm * BM * DM + u.pn * BM + wc * 32 + (unsigned)((wr * 64 + fre) * DM + 8 * fqe);
        float sa[2][4];
        u32x4 pre[2][4][2];
#pragma unroll
        for (int ai = 0; ai < 2; ++ai)
#pragma unroll
            for (int m = 0; m < 4; ++m)
#pragma unroll
                for (int bj = 0; bj < 2; ++bj) pre[ai][m][bj] = *(const u32x4*)(xt + (ai * HALF + m * 16) * DM + bj * HALF);
#pragma unroll
        for (int ai = 0; ai < 2; ++ai) {
#pragma unroll
            for (int m = 0; m < 4; ++m) {
                float ss = 0.f;
#pragma unroll
                for (int bj = 0; bj < 2; ++bj) { const u32x4 pw = pre[ai][m][bj];
                    const f32x4 v0 = acc[ai][bj][m][0] + (f32x4){h_lo(pw.x), h_hi(pw.x), h_lo(pw.y), h_hi(pw.y)}, v1 = acc[ai][bj][m][1] + (f32x4){h_lo(pw.z), h_hi(pw.z), h_lo(pw.w), h_hi(pw.w)};
                    ss += sq8(v0, v1);
                    *(u32x4*)(xt + (ai * HALF + m * 16) * DM + bj * HALF) = pack8h(v0, v1); }
                sa[ai][m] = quad_row_sum(ss);
            }
        }
#pragma unroll
        for (int ai = 0; ai < 2; ++ai) { const float v = fqe == 0 ? sa[ai][0] : fqe == 1 ? sa[ai][1] : fqe == 2 ? sa[ai][2] : sa[ai][3];
            slab[((size_t)u.pm * BM + ai * HALF + wr * 64 + fqe * 16 + fre) * 32 + u.pn * 4 + wc] = v; }
    }
};
struct EpiGate {
    const bf16_t* xb; const bf16_t* pe; bf16_t* xbn; float* slab; RowScale rs;
    __device__ __forceinline__ void prep(const Unit& u, int ui, LAS unsigned char* lds, int tid) const { rs.fill(lds, ui, u.pm * BM, tid); }
    __device__ __forceinline__ void operator()(const Acc& acc, const Unit& u, int ui, int wr, int wc, int fr, int fq, LAS unsigned char* lds) const {
        int fre = fr, fqe = fq; asm volatile("" : "+v"(fre), "+v"(fqe));
        const size_t t0 = (size_t)u.pm * BM * DM + u.pn * BM + wc * 32 + (unsigned)((wr * 64 + fre) * DM + 8 * fqe);
        float sa[2][4];
#pragma unroll
        for (int ai = 0; ai < 2; ++ai)
            {
                u32x4 px[4][2], pp[4][2];
#pragma unroll
                for (int mm = 0; mm < 4; ++mm)
#pragma unroll
                    for (int bj = 0; bj < 2; ++bj) { const size_t o_ = t0 + (ai * HALF + mm * 16) * DM + bj * HALF;
                        px[mm][bj] = *(const u32x4*)(xb + o_); pp[mm][bj] = *(const u32x4*)(pe + o_); }
#pragma unroll
                for (int mm = 0; mm < 4; ++mm) {
                    const int m = mm;
                    const int rl = ai * HALF + wr * 64 + m * 16 + fre;
                    const float s = rs.get(lds, ui, rl) * -1.4426950408889634f; float ss = 0.f;
#pragma unroll
                    for (int bj = 0; bj < 2; ++bj) { const u32x4 xw = px[mm][bj], pw = pp[mm][bj];
                        const f32x4 x0 = {h_lo(xw.x), h_hi(xw.x), h_lo(xw.y), h_hi(xw.y)}, x1 = {h_lo(xw.z), h_hi(xw.z), h_lo(xw.w), h_hi(xw.w)};
                        const f32x4 p0 = {bf_lo(pw.x), bf_hi(pw.x), bf_lo(pw.y), bf_hi(pw.y)}, p1 = {bf_lo(pw.z), bf_hi(pw.z), bf_lo(pw.w), bf_hi(pw.w)};
                        f32x4 v0, v1;
#pragma unroll
                        for (int e = 0; e < 4; ++e) { const float g0_ = __builtin_amdgcn_rcpf(1.f + __builtin_amdgcn_exp2f(acc[ai][bj][m][0][e] * s)), g1_ = __builtin_amdgcn_rcpf(1.f + __builtin_amdgcn_exp2f(acc[ai][bj][m][1][e] * s));
                            v0[e] = x0[e] + p0[e] * g0_; v1[e] = x1[e] + p1[e] * g1_; }
                        ss += sq8(v0, v1);
                        *(u32x4*)(xbn + t0 + (ai * HALF + m * 16) * DM + bj * HALF) = pack8h(v0, v1); }
                    sa[ai][m] = quad_row_sum(ss);
                }
            }
#pragma unroll
        for (int ai = 0; ai < 2; ++ai) { const float v = fqe == 0 ? sa[ai][0] : fqe == 1 ? sa[ai][1] : fqe == 2 ? sa[ai][2] : sa[ai][3];
            slab[((size_t)u.pm * BM + ai * HALF + wr * 64 + fqe * 16 + fre) * 32 + u.pn * 4 + wc] = v; }
    }
};
struct EpiKV8 {
    unsigned char* kn8; unsigned char* v8; RowScale rs;
    __device__ __forceinline__ void prep(const Unit& u, int ui, LAS unsigned char* lds, int tid) const { rs.fill(lds, ui, u.pm * BM, tid); }
    __device__ __forceinline__ void operator()(const Acc& acc, const Unit& u, int ui, int wr, int wc, int fr, int fq, LAS unsigned char* lds) const {
        int fre = fr, fqe = fq; asm volatile("" : "+v"(fre), "+v"(fqe));
        const LAS float* tbl = (const LAS float*)(lds + TBL_OFF) + (ui & 1) * 256;
#pragma unroll
        for (int ai = 0; ai < 2; ++ai) {
            const size_t blk = ((size_t)(u.pm * 4 + ai * 2 + wr) * 6 + u.pn) * 8192;
            unsigned kw[4][2], vw[4][2];
#pragma unroll
            for (int m = 0; m < 4; ++m) {
                { const float s = tbl[ai * HALF + wr * 64 + m * 16 + fre];
                  const f32x4 v0 = acc[ai][0][m][0] * s, v1 = acc[ai][0][m][1] * s;
                  int w0 = 0, w1 = 0;
                  w0 = __builtin_amdgcn_cvt_pk_fp8_f32(v0[0], v0[1], w0, false); w0 = __builtin_amdgcn_cvt_pk_fp8_f32(v0[2], v0[3], w0, true);
                  w1 = __builtin_amdgcn_cvt_pk_fp8_f32(v1[0], v1[1], w1, false); w1 = __builtin_amdgcn_cvt_pk_fp8_f32(v1[2], v1[3], w1, true);
                  kw[m][0] = (unsigned)w0; kw[m][1] = (unsigned)w1; }
                { const f32x4 s4 = *(const LAS f32x4*)(tbl + ai * HALF + wr * 64 + m * 16 + 4 * fqe);
#pragma unroll
                  for (int n = 0; n < 2; ++n) { const f32x4 v = acc[ai][1][m][n] * s4; int w = 0;
                      w = __builtin_amdgcn_cvt_pk_fp8_f32(v[0], v[1], w, false); w = __builtin_amdgcn_cvt_pk_fp8_f32(v[2], v[3], w, true); vw[m][n] = (unsigned)w; } }
            }
#pragma unroll
            for (int mp = 0; mp < 2; ++mp) {
                const auto r0 = __builtin_amdgcn_permlane16_swap(kw[2 * mp][0], kw[2 * mp + 1][0], false, false);
                const auto r1 = __builtin_amdgcn_permlane16_swap(kw[2 * mp][1], kw[2 * mp + 1][1], false, false);
                const int key = (2 * mp + (fqe & 1)) * 16 + fre;
                *(u32x4*)(kn8 + blk + (wc * 2 + (fqe >> 1)) * 1024 + key * 16) = (u32x4){r0[0], r1[0], r0[1], r1[1]};
            }
#pragma unroll
            for (int n = 0; n < 2; ++n) {
                const auto e0 = __builtin_amdgcn_permlane32_swap(vw[0][n], vw[2][n], false, false);
                const auto e1 = __builtin_amdgcn_permlane32_swap(vw[1][n], vw[3][n], false, false);
                const int col = wc * 32 + 8 * (fre >> 2) + 4 * n + (fre & 3), g = 2 * (fqe & 1) + (fqe >> 1);
                *(u32x4*)(v8 + blk + col * 64 + ((g ^ ((col >> 2) & 3)) << 4)) = (u32x4){e0[0], e0[1], e1[0], e1[1]};
            }
        }
    }
};
}

namespace att {
constexpr float LOG2E = 1.4426950408889634f;
constexpr float THR = 6.f;
__device__ __forceinline__ int crow(int r, int hi) { return (r & 3) + 8 * (r >> 2) + 4 * hi; }
template <int KIND> struct Cfg;
template <> struct Cfg<0> { static constexpr int NDQ = 12, NDV = 4, H = 6; static constexpr float SCALE = 0.07216878364870323f; };
template <> struct Cfg<1> { static constexpr int NDQ = 4, NDV = 2, H = 12; static constexpr float SCALE = 0.125f; };
template <> struct Cfg<2> { static constexpr int NDQ = 4, NDV = 2, H = 8; static constexpr float SCALE = 0.125f; };

struct Ctx {
    bf16_t* proj; const bf16_t* q; const bf16_t* kv; const unsigned char* kf8; const unsigned char* gv8; const unsigned char* kn8; const unsigned char* v8; const unsigned char* kr8;
    const f32x2* ropeT; const f32x2* rowT; const f32x2* colT;
    const float* gq_norm; const float* gk_norm; const float* rpb;
};

template <int NDV> __device__ __forceinline__ int v_st(int k, int c) { const int kk = (k & ~0xC) | ((k & 4) << 1) | ((k & 8) >> 1); return ((kk >> 3) * NDV + (c >> 5)) * 512 + ((kk & 7) * 32 + (c & 31)) * 2; }
__device__ __forceinline__ int v_rd_base(int lane) { return ((lane & 3) << 3) | (((lane >> 2) & 3) << 6) | (((lane >> 4) & 1) << 5) | (((lane >> 5) & 1) << 8); }
template <int OFF> __device__ __forceinline__ s16x4 tr_read(unsigned vb) { s16x4 r; asm volatile("ds_read_b64_tr_b16 %0, %1 offset:%2" : "=&v"(r) : "v"(vb), "i"(OFF) : "memory"); return r; }

template <int C1000> struct Dummy {};
template <int KIND> __device__ __forceinline__ void softmax_tile(f32x16& p0, f32x16& p1, float& m_reg, float& l_reg, float& alpha, bf16x8& pa0, bf16x8& pa1, bf16x8& pa2, bf16x8& pa3) {
    constexpr float SC = Cfg<KIND>::SCALE, C = SC * LOG2E;
    float pmax = p0[0];
#pragma unroll
    for (int r = 1; r < 16; ++r) pmax = fmaxf(pmax, p0[r]);
#pragma unroll
    for (int r = 0; r < 16; ++r) pmax = fmaxf(pmax, p1[r]);
    { auto rr = __builtin_amdgcn_permlane32_swap(__float_as_uint(pmax), __float_as_uint(pmax), false, false);
      pmax = fmaxf(__uint_as_float(rr[0]), __uint_as_float(rr[1])); }
    float mn;
    if (__builtin_expect(__all(pmax - m_reg <= THR / SC), 1)) { mn = m_reg; alpha = 1.f; }
    else { mn = fmaxf(m_reg, pmax); alpha = __builtin_amdgcn_exp2f((m_reg - mn) * C); m_reg = mn; }
    const float mnC = -mn * C;
#pragma unroll
    for (int r = 0; r < 16; ++r) { p0[r] = __builtin_amdgcn_exp2f(fmaf(p0[r], C, mnC)); p1[r] = __builtin_amdgcn_exp2f(fmaf(p1[r], C, mnC)); }
    float ps = 0.f;
#pragma unroll
    for (int r = 0; r < 16; ++r) ps += p0[r];
#pragma unroll
    for (int r = 0; r < 16; ++r) ps += p1[r];
    { auto rr = __builtin_amdgcn_permlane32_swap(__float_as_uint(ps), __float_as_uint(ps), false, false);
      ps = __uint_as_float(rr[0]) + __uint_as_float(rr[1]); }
    l_reg = l_reg * alpha + ps;
#define PK4(P, BASE, OUT) do { unsigned a0 = cvt_pk_bf16(P[BASE + 0], P[BASE + 1]), a1 = cvt_pk_bf16(P[BASE + 2], P[BASE + 3]);   \
    unsigned b0 = cvt_pk_bf16(P[BASE + 4], P[BASE + 5]), b1 = cvt_pk_bf16(P[BASE + 6], P[BASE + 7]);                              \
    auto r0 = __builtin_amdgcn_permlane32_swap(a0, b0, false, false); auto r1 = __builtin_amdgcn_permlane32_swap(a1, b1, false, false); \
    u32x4 w = {r0[0], r1[0], r0[1], r1[1]}; OUT = __builtin_bit_cast(bf16x8, w); } while (0)
    PK4(p0, 0, pa0); PK4(p0, 8, pa1); PK4(p1, 0, pa2); PK4(p1, 8, pa3);
#undef PK4
}
constexpr float THR2 = 8.f;
__device__ __forceinline__ void softmax_ref(f32x16& p0, f32x16& p1, float& mhat, float& l_reg, float& alpha, bool first, bf16x8& pa0, bf16x8& pa1, bf16x8& pa2, bf16x8& pa3) {
    float a_ = fmaxf(fmaxf(p0[0], p0[1]), p1[0]), b_ = fmaxf(fmaxf(p0[2], p0[3]), p1[1]); a_ = fmaxf(fmaxf(a_, p1[2]), p1[3]);
#pragma unroll
    for (int r = 4; r < 16; r += 4) { a_ = fmaxf(fmaxf(a_, p0[r]), p0[r + 1]); b_ = fmaxf(fmaxf(b_, p0[r + 2]), p0[r + 3]); a_ = fmaxf(fmaxf(a_, p1[r]), p1[r + 1]); b_ = fmaxf(fmaxf(b_, p1[r + 2]), p1[r + 3]); }
    float rm = fmaxf(a_, b_);
    { auto rr = __builtin_amdgcn_permlane32_swap(__float_as_uint(rm), __float_as_uint(rm), false, false); rm = fmaxf(__uint_as_float(rr[0]), __uint_as_float(rr[1])); }
    alpha = 1.f;
    const bool ok = first ? (fabsf(rm) <= THR2) : (rm - mhat <= THR2);
    if (__builtin_expect(!__all(ok), 0)) { const float mn = first ? rm : fmaxf(mhat, rm); alpha = first ? 1.f : __builtin_amdgcn_exp2f(mhat - mn); mhat = mn; }
    if (__builtin_expect(__any(mhat != 0.f), 0)) {
#pragma unroll
        for (int r = 0; r < 16; ++r) { p0[r] -= mhat; p1[r] -= mhat; } }
#pragma unroll
    for (int r = 0; r < 16; ++r) { p0[r] = __builtin_amdgcn_exp2f(p0[r]); p1[r] = __builtin_amdgcn_exp2f(p1[r]); }
    float ps0 = 0.f, ps1 = 0.f;
#pragma unroll
    for (int r = 0; r < 16; ++r) { ps0 += p0[r]; ps1 += p1[r]; }
    float ps = ps0 + ps1;
    { auto rr = __builtin_amdgcn_permlane32_swap(__float_as_uint(ps), __float_as_uint(ps), false, false); ps = __uint_as_float(rr[0]) + __uint_as_float(rr[1]); }
    l_reg = l_reg * alpha + ps;
#define PK4(P, BASE, OUT) do { unsigned a0 = cvt_pk_bf16(P[BASE + 0], P[BASE + 1]), a1 = cvt_pk_bf16(P[BASE + 2], P[BASE + 3]);   \
    unsigned b0 = cvt_pk_bf16(P[BASE + 4], P[BASE + 5]), b1 = cvt_pk_bf16(P[BASE + 6], P[BASE + 7]);                              \
    auto r0 = __builtin_amdgcn_permlane32_swap(a0, b0, false, false); auto r1 = __builtin_amdgcn_permlane32_swap(a1, b1, false, false); \
    u32x4 w = {r0[0], r1[0], r0[1], r1[1]}; OUT = __builtin_bit_cast(bf16x8, w); } while (0)
    PK4(p0, 0, pa0); PK4(p0, 8, pa1); PK4(p1, 0, pa2); PK4(p1, 8, pa3);
#undef PK4
}
template <int NDQ> __device__ __forceinline__ void qkt(f32x16& p0, f32x16& p1, const LAS unsigned char* Kb, const bf16x8* qr, int r32, int hi) {
    p0 = f32x16{}; p1 = f32x16{};
    const LAS unsigned char* kp = Kb + hi * 1040 + r32 * 16;
    constexpr int PF = 2;
    bf16x8 kb0[PF], kb1[PF];
#pragma unroll
    for (int d0 = 0; d0 < PF; ++d0) { kb0[d0] = *(const LAS bf16x8*)(kp + d0 * 2080); kb1[d0] = *(const LAS bf16x8*)(kp + d0 * 2080 + 512); }
    SBAR();
#pragma unroll
    for (int d0 = 0; d0 < NDQ; ++d0) {
        p0 = __builtin_amdgcn_mfma_f32_32x32x16_bf16(kb0[d0 % PF], qr[d0], p0, 0, 0, 0);
        p1 = __builtin_amdgcn_mfma_f32_32x32x16_bf16(kb1[d0 % PF], qr[d0], p1, 0, 0, 0);
        if (d0 + PF < NDQ) { kb0[d0 % PF] = *(const LAS bf16x8*)(kp + (d0 + PF) * 2080); kb1[d0 % PF] = *(const LAS bf16x8*)(kp + (d0 + PF) * 2080 + 512); }
        SBAR();
    }
}
__device__ __forceinline__ void qkt_mla(f32x16& p0, f32x16& p1, const LAS unsigned char* Kb, const bf16x8* qr, const LAS unsigned char* qrope, int r32, int hi) {
    p0 = f32x16{}; p1 = f32x16{};
    const LAS unsigned char* kp = Kb + hi * 1040 + r32 * 16;
    constexpr int PF = 2;
    bf16x8 kb0[PF], kb1[PF], qx[4];
#pragma unroll
    for (int d0 = 0; d0 < PF; ++d0) { kb0[d0] = *(const LAS bf16x8*)(kp + d0 * 2080); kb1[d0] = *(const LAS bf16x8*)(kp + d0 * 2080 + 512); }
#pragma unroll
    for (int d0 = 0; d0 < 4; ++d0) qx[d0] = *(const LAS bf16x8*)(qrope + d0 * 1024);
    SBAR();
#pragma unroll
    for (int d0 = 0; d0 < 12; ++d0) {
        const bf16x8 q = (d0 < 8) ? qr[d0 < 8 ? d0 : 0] : qx[d0 >= 8 ? d0 - 8 : 0];
        p0 = __builtin_amdgcn_mfma_f32_32x32x16_bf16(kb0[d0 % PF], q, p0, 0, 0, 0);
        p1 = __builtin_amdgcn_mfma_f32_32x32x16_bf16(kb1[d0 % PF], q, p1, 0, 0, 0);
        if (d0 + PF < 12) { kb0[d0 % PF] = *(const LAS bf16x8*)(kp + (d0 + PF) * 2080); kb1[d0 % PF] = *(const LAS bf16x8*)(kp + (d0 + PF) * 2080 + 512); }
        SBAR();
    }
}
template <int NDV, int D0> __device__ __forceinline__ void pv_one(f32x16& od, unsigned vb, bf16x8 pa0, bf16x8 pa1, bf16x8 pa2, bf16x8 pa3) {
    constexpr int KS = NDV * 1024, HF = NDV * 512;
    const s16x4 l0 = tr_read<D0 * 512 + 0 * KS>(vb), h0 = tr_read<D0 * 512 + 0 * KS + HF>(vb), l1 = tr_read<D0 * 512 + 1 * KS>(vb), h1 = tr_read<D0 * 512 + 1 * KS + HF>(vb);
    const s16x4 l2 = tr_read<D0 * 512 + 2 * KS>(vb), h2 = tr_read<D0 * 512 + 2 * KS + HF>(vb), l3 = tr_read<D0 * 512 + 3 * KS>(vb), h3 = tr_read<D0 * 512 + 3 * KS + HF>(vb);
    asm volatile("s_waitcnt lgkmcnt(0)" ::: "memory"); SBAR();
#define PK(L, H) (bf16x8){L[0], L[1], L[2], L[3], H[0], H[1], H[2], H[3]}
    od = __builtin_amdgcn_mfma_f32_32x32x16_bf16(pa0, PK(l0, h0), od, 0, 0, 0);
    od = __builtin_amdgcn_mfma_f32_32x32x16_bf16(pa1, PK(l1, h1), od, 0, 0, 0);
    od = __builtin_amdgcn_mfma_f32_32x32x16_bf16(pa2, PK(l2, h2), od, 0, 0, 0);
    od = __builtin_amdgcn_mfma_f32_32x32x16_bf16(pa3, PK(l3, h3), od, 0, 0, 0);
#undef PK
}


typedef short v4i16_t __attribute__((ext_vector_type(4)));
__device__ __forceinline__ s16x4 vtr(const LAS unsigned char* p) { return __builtin_bit_cast(s16x4, __builtin_amdgcn_ds_read_tr16_b64_v4i16((LAS v4i16_t*)p)); }
struct VF { s16x4 l0, h0, l1, h1, l2, h2, l3, h3; };
template <int NDV, int D0> __device__ __forceinline__ void v_read(VF& f, const LAS unsigned char* vp) {
    constexpr int KS = NDV * 1024, HF = NDV * 512, B = D0 * 512;
    f.l0 = vtr(vp + B); f.h0 = vtr(vp + B + HF); f.l1 = vtr(vp + B + KS); f.h1 = vtr(vp + B + KS + HF);
    f.l2 = vtr(vp + B + 2 * KS); f.h2 = vtr(vp + B + 2 * KS + HF); f.l3 = vtr(vp + B + 3 * KS); f.h3 = vtr(vp + B + 3 * KS + HF);
}
__device__ __forceinline__ void pv_mma(f32x16& od, const VF& f, bf16x8 pa0, bf16x8 pa1, bf16x8 pa2, bf16x8 pa3) {
#define PK(L, H) (bf16x8){L[0], L[1], L[2], L[3], H[0], H[1], H[2], H[3]}
    od = __builtin_amdgcn_mfma_f32_32x32x16_bf16(pa0, PK(f.l0, f.h0), od, 0, 0, 0);
    od = __builtin_amdgcn_mfma_f32_32x32x16_bf16(pa1, PK(f.l1, f.h1), od, 0, 0, 0);
    od = __builtin_amdgcn_mfma_f32_32x32x16_bf16(pa2, PK(f.l2, f.h2), od, 0, 0, 0);
    od = __builtin_amdgcn_mfma_f32_32x32x16_bf16(pa3, PK(f.l3, f.h3), od, 0, 0, 0);
#undef PK
}

constexpr int EPI_PITCH = 36, EPI_WAVE_BYTES = 32 * EPI_PITCH * 4;
template <class RowOff>
__device__ __forceinline__ void epi_block(LAS float* S, const f32x16& od, const LAS float* ltab, int lane, const bf16_t* gate0, bf16_t* out0, RowOff rowoff, const bool DRY) {
    const int r32 = lane & 31, hi = lane >> 5;
#pragma unroll
    for (int r = 0; r < 16; ++r) { const int orow = crow(r, hi); S[orow * EPI_PITCH + r32] = od[r] * __builtin_amdgcn_rcpf(ltab[orow]); }
    asm volatile("s_waitcnt lgkmcnt(0)" ::: "memory");
#pragma unroll
    for (int p = 0; p < 2; ++p) {
        const int t = lane + 64 * p, row = t >> 2, cg = t & 3;
        const f32x4 a = *(const LAS f32x4*)(S + row * EPI_PITCH + cg * 8), b = *(const LAS f32x4*)(S + row * EPI_PITCH + cg * 8 + 4);
        const size_t ro = rowoff(row) + cg * 8;
        const u32x4 gw = *(const u32x4*)(gate0 + ro);
        const float gt[8] = {bf_lo(gw.x), bf_hi(gw.x), bf_lo(gw.y), bf_hi(gw.y), bf_lo(gw.z), bf_hi(gw.z), bf_lo(gw.w), bf_hi(gw.w)};
        float y[8];
#pragma unroll
        for (int i = 0; i < 8; ++i) y[i] = (i < 4 ? a[i] : b[i - 4]) * gt[i] * __builtin_amdgcn_rcpf(1.f + __builtin_amdgcn_exp2f(-gt[i] * LOG2E));
        if (!DRY) *(u32x4*)(out0 + ro) = (u32x4){cvt_pk_bf16(y[0], y[1]), cvt_pk_bf16(y[2], y[3]), cvt_pk_bf16(y[4], y[5]), cvt_pk_bf16(y[6], y[7])};
    }
    asm volatile("s_waitcnt lgkmcnt(0)" ::: "memory");
}

__device__ __forceinline__ void na_unit(const Ctx& c, int s0, int slen, int h, int qb, LAS unsigned char* lds, const bool DRY) {
    constexpr int KB = 8320, VB = 8192;
    const int tid = opaque_tid(), lane = tid & 63, r32 = lane & 31, hi = lane >> 5;
    const int wid = __builtin_amdgcn_readfirstlane(tid >> 6);
    const int rows = slen >> 6, r0 = qb * 4;
    const int lo = min(max(r0 - 4, 0), rows - 8), hi_r = min(max(r0 + 3 - 4, 0), rows - 8) + 7;
    const int NT = hi_r - lo + 1;
    const int rA = r0 + 2 * (wid >> 2);
    const int c0 = 16 * (wid & 3), kc0 = min(max(c0 - 8, 0), 32);
    const int wlo = min(max(rA - 4, 0), rows - 8), whi = min(max(rA + 1 - 4, 0), rows - 8) + 8;
    const int qrow = rA + (r32 >> 4), qcol = c0 + (r32 & 15);
    const int rsq = min(max(qrow - 4, 0), rows - 8), csq = min(max(qcol - 8, 0), 48);
    const int tq = qrow * 64 + qcol;
    const size_t Rq = (size_t)(s0 + tq);
    bf16x8 qr[4];
    { const bf16_t* qp = c.proj + Rq * LDP + C_NAQ + h * 64 + hi * 8;
#pragma unroll
      for (int d0 = 0; d0 < 4; ++d0) qr[d0] = *(const bf16x8*)(qp + d0 * 16); }
    unsigned cmask = 0u;
#pragma unroll
    for (int r = 0; r < 16; ++r) { const int kc = kc0 + crow(r, hi); cmask |= ((kc >= csq) && (kc < csq + 16)) ? (1u << r) : 0u; }
    constexpr int NA_KOFF = 0, NA_VOFF = 50176, NA_WSOFF = NA_VOFF + 6 * 8192, NA_BOFF2 = NA_WSOFF + 2048;
    static_assert(6 * 8320 <= NA_VOFF && NA_BOFF2 + 2048 <= RING_BYTES, "NA LDS map");
    LAS unsigned char* Kn = lds + NA_KOFF; LAS unsigned char* Vn = lds + NA_VOFF;
    const int kr_ = tid >> 3, cr_ = tid & 7;
    const bf16_t* gk0 = c.proj + ((size_t)s0 + (size_t)lo * 64 + kr_) * LDP + C_NAK + h * 64 + cr_ * 8;
    constexpr size_t tstride = (size_t)64 * LDP;
    const int lk0 = cr_ * 1040 + kr_ * 16, lv0 = v_st<2>(kr_, cr_ * 8);
    bf16x8 sk[6], sv[6];
#define NA_LOAD(t0, n) do { _Pragma("unroll") for (int t = 0; t < 6; ++t) if (t < (n)) { sk[t] = *(const bf16x8*)(gk0 + (size_t)((t0) + t) * tstride); sv[t] = *(const bf16x8*)(gk0 + (size_t)((t0) + t) * tstride + (C_NAV - C_NAK)); } } while (0)
#define NA_WRITE(n) do { _Pragma("unroll") for (int t = 0; t < 6; ++t) if (t < (n)) { *(LAS bf16x8*)(Kn + t * KB + lk0) = sk[t]; *(LAS bf16x8*)(Vn + t * VB + lv0) = sv[t]; } } while (0)
    int va[2][2];
#pragma unroll
    for (int ks = 0; ks < 2; ++ks)
#pragma unroll
        for (int hf = 0; hf < 2; ++hf) { const int k = kc0 + 16 * ks + 8 * hi + 4 * hf; const int kk = (k & ~0xC) | ((k & 4) << 1) | ((k & 8) >> 1);
            va[ks][hf] = ((kk >> 3) * 2) * 512 + (kk & 7) * 64 + (((lane & 3) << 3) | (((lane >> 2) & 3) << 6) | (((lane >> 4) & 1) << 5)); }
    const LAS unsigned char* kp0 = Kn + hi * 1040 + (kc0 + r32) * 16;
    LAS float* wsn = (LAS float*)(lds + NA_WSOFF) + wid * 64;
    LAS float* bn = (LAS float*)(lds + NA_BOFF2);
    for (int i = tid; i < 15 * 32; i += 512) { const int di = i >> 5, dj = i & 31; bn[i] = (dj < 31) ? c.rpb[(h * 15 + di) * 31 + dj] * LOG2E : 0.f; }
    float mhat = 0.f, l_reg = 0.f; bool seen = false; f32x16 o[2];
    o[0] = f32x16{}; o[1] = f32x16{};
    const int nB = NT - 6;
    NA_LOAD(0, 6); NA_WRITE(6); NA_LOAD(6, nB);
    __syncthreads();
    for (int ch = 0; ch < 2; ++ch) {
        const int nt = ch ? nB : 6;
#pragma nounroll
        for (int t = 0; t < nt; ++t) {
            const int kr = lo + ch * 6 + t;
            if (kr >= wlo && kr < whi) {
                f32x16 p = f32x16{};
                const LAS unsigned char* kp = kp0 + t * KB;
#pragma unroll
                for (int d0 = 0; d0 < 4; ++d0) p = __builtin_amdgcn_mfma_f32_32x32x16_bf16(*(const LAS bf16x8*)(kp + d0 * 2080), qr[d0], p, 0, 0, 0);
                const bool rowok = (kr >= rsq) && (kr < rsq + 8);
                const int di = min(max(kr - qrow + 7, 0), 14);
                const LAS float* br = bn + di * 32 + (15 - qcol) + kc0;
#pragma unroll
                for (int r = 0; r < 16; ++r) { const bool v = rowok && ((cmask >> r) & 1u); const float bv = br[v ? crow(r, hi) : (qcol - kc0)]; p[r] = v ? p[r] + bv : -1e30f; }
                float a_ = fmaxf(fmaxf(p[0], p[1]), p[2]), b_ = fmaxf(fmaxf(p[3], p[4]), p[5]);
                a_ = fmaxf(fmaxf(a_, p[6]), p[7]); b_ = fmaxf(fmaxf(b_, p[8]), p[9]); a_ = fmaxf(fmaxf(a_, p[10]), p[11]); b_ = fmaxf(fmaxf(b_, p[12]), p[13]); a_ = fmaxf(fmaxf(a_, p[14]), p[15]);
                float rm = fmaxf(a_, b_); rm = fmaxf(rm, part32(rm));
                const bool has = rm > -1e29f;
                float alpha = 1.f;
                const bool okl = !has || (seen ? (rm - mhat <= THR2) : (fabsf(rm) <= THR2));
                if (__builtin_expect(!__all(okl), 0)) { if (has) { const float mn = seen ? fmaxf(mhat, rm) : rm; alpha = seen ? __builtin_amdgcn_exp2f(mhat - mn) : 1.f; mhat = mn; } }
                seen = seen || has;
                if (__builtin_expect(__any(mhat != 0.f), 0)) {
#pragma unroll
                    for (int r = 0; r < 16; ++r) p[r] -= mhat; }
#pragma unroll
                for (int r = 0; r < 16; ++r) p[r] = __builtin_amdgcn_exp2f(p[r]);
                float ps = 0.f;
#pragma unroll
                for (int r = 0; r < 16; ++r) ps += p[r];
                ps += part32(ps);
                l_reg = l_reg * alpha + ps;
                bf16x8 paA, paB;
#define PK4(P, BASE, OUT) do { unsigned a0 = cvt_pk_bf16(P[BASE + 0], P[BASE + 1]), a1 = cvt_pk_bf16(P[BASE + 2], P[BASE + 3]);   \
    unsigned b0 = cvt_pk_bf16(P[BASE + 4], P[BASE + 5]), b1 = cvt_pk_bf16(P[BASE + 6], P[BASE + 7]);                              \
    auto r0_ = __builtin_amdgcn_permlane32_swap(a0, b0, false, false); auto r1_ = __builtin_amdgcn_permlane32_swap(a1, b1, false, false); \
    u32x4 w = {r0_[0], r1_[0], r0_[1], r1_[1]}; OUT = __builtin_bit_cast(bf16x8, w); } while (0)
                PK4(p, 0, paA); PK4(p, 8, paB);
#undef PK4
                if (__any(alpha < 1.f)) { if (hi == 0) wsn[r32] = alpha; LDS_WAIT();
#pragma unroll
                    for (int d = 0; d < 2; ++d)
#pragma unroll
                        for (int r = 0; r < 16; ++r) o[d][r] *= wsn[crow(r, hi)];
                    LDS_WAIT(); }
                const LAS unsigned char* vp = Vn + t * VB;
                const s16x4 l0 = vtr(vp + va[0][0]), h0 = vtr(vp + va[0][1]), l1 = vtr(vp + va[1][0]), h1 = vtr(vp + va[1][1]);
                const s16x4 m0 = vtr(vp + va[0][0] + 512), n0 = vtr(vp + va[0][1] + 512), m1 = vtr(vp + va[1][0] + 512), n1 = vtr(vp + va[1][1] + 512);
#define PK(L, H) (bf16x8){L[0], L[1], L[2], L[3], H[0], H[1], H[2], H[3]}
                o[0] = __builtin_amdgcn_mfma_f32_32x32x16_bf16(paA, PK(l0, h0), o[0], 0, 0, 0);
                o[1] = __builtin_amdgcn_mfma_f32_32x32x16_bf16(paA, PK(m0, n0), o[1], 0, 0, 0);
                o[0] = __builtin_amdgcn_mfma_f32_32x32x16_bf16(paB, PK(l1, h1), o[0], 0, 0, 0);
                o[1] = __builtin_amdgcn_mfma_f32_32x32x16_bf16(paB, PK(m1, n1), o[1], 0, 0, 0);
#undef PK
            }
        }
        __syncthreads();
        if (ch == 0) { NA_WRITE(nB); __syncthreads(); }
    }
#undef NA_LOAD
#undef NA_WRITE
    LAS float* wsf = wsn;
    if (hi == 0) wsf[32 + r32] = l_reg; LDS_WAIT();
    { int le = lane; asm volatile("" : "+v"(le));
      LAS float* S = (LAS float*)(lds + NA_KOFF + wid * EPI_WAVE_BYTES);
      bf16_t* ob = c.proj + (size_t)s0 * LDP + C_NAQ + h * 64;
      auto rowoff = [&](int row) { return (size_t)((rA + (row >> 4)) * 64 + c0 + (row & 15)) * LDP; };
#pragma unroll
      for (int d0 = 0; d0 < 2; ++d0) epi_block(S, o[d0], wsf + 32, le, ob + (C_NAG - C_NAQ) + d0 * 32, ob + d0 * 32, rowoff, DRY); }
    LDS_WAIT();
    __syncthreads();
}


typedef int v8i_t __attribute__((ext_vector_type(8)));
__device__ __forceinline__ int g8_slot(int k) { const int kk = k & 31; return 32 * ((kk >> 2) & 1) + (kk & 3) + 4 * (kk >> 3) + ((k >> 5) << 4); }
constexpr int G9_KB = 4224, G9_VB = 4096, G9_KOFF = 0, G9_VOFF = 4 * G9_KB, G9_WSOFF = G9_VOFF + 4 * G9_VB, G9_QOFF = G9_WSOFF + 2048;
static_assert(G9_QOFF + 8 * 6144 + 8 * EPI_WAVE_BYTES <= RING_BYTES, "gqa9 LDS map");
__device__ __forceinline__ void gqa9_unit(const Ctx& c, int s0, int slen, int kvh, int qb, LAS unsigned char* lds, const bool DRY) {
    const int tid = opaque_tid(), lane = tid & 63, r32 = lane & 31, hi = lane >> 5;
    const int wid = __builtin_amdgcn_readfirstlane(tid >> 6);
    LAS unsigned char* Kl = lds + G9_KOFF; LAS unsigned char* Vl = lds + G9_VOFF;
    LAS float* wsf = (LAS float*)(lds + G9_WSOFF) + wid * 64;
    const int tq = qb * 256 + wid * 32 + r32;
    const size_t Rq = (size_t)(s0 + tq);
    constexpr float CQ = 0.125f * LOG2E * 8.0f;
    LAS unsigned char* Qs = lds + G9_QOFF + wid * 6144 + lane * 16;
    {
        const f32x2* tb = (hi == 0) ? c.rowT + (tq >> 6) * 16 : c.colT + (tq & 63) * 16;
        const float* gqh = c.gq_norm + hi * 32;
#pragma nounroll
        for (int hh = 0; hh < 3; ++hh) {
            bf16x8 raw[4];
#pragma unroll
            for (int d = 0; d < 4; ++d) raw[d] = *(const bf16x8*)(c.proj + Rq * LDP + C_GQ + (kvh * 3 + hh) * 64 + hi * 32 + d * 8);
            float ss = 0.f;
#pragma unroll
            for (int i = 0; i < 32; ++i) { const float xv = bf2f(raw[i >> 3][i & 7]); ss += xv * xv; }
            ss += part32(ss);
            const float rstd = CQ / sqrtf(ss * (1.0f / 64.0f) + EPS);
            int qw[8];
#pragma unroll
            for (int w = 0; w < 4; ++w) {
                float y1[4], y2[4];
#pragma unroll
                for (int t = 0; t < 4; ++t) { const int e = 4 * w + t; const f32x2 cs = tb[e];
                    const float x1 = bf2f(raw[e >> 3][e & 7]) * rstd * gqh[e], x2 = bf2f(raw[(e + 16) >> 3][(e + 16) & 7]) * rstd * gqh[e + 16];
                    y1[t] = x1 * cs.x - x2 * cs.y; y2[t] = x2 * cs.x + x1 * cs.y; }
                int pa_ = 0, pb_ = 0;
                pa_ = __builtin_amdgcn_cvt_pk_fp8_f32(y1[0], y1[1], pa_, false); pa_ = __builtin_amdgcn_cvt_pk_fp8_f32(y1[2], y1[3], pa_, true);
                pb_ = __builtin_amdgcn_cvt_pk_fp8_f32(y2[0], y2[1], pb_, false); pb_ = __builtin_amdgcn_cvt_pk_fp8_f32(y2[2], y2[3], pb_, true);
                qw[w] = pa_; qw[4 + w] = pb_;
            }
            *(LAS u32x4*)(Qs + (hh * 2) * 1024) = (u32x4){(unsigned)qw[0], (unsigned)qw[1], (unsigned)qw[2], (unsigned)qw[3]};
            *(LAS u32x4*)(Qs + (hh * 2 + 1) * 1024) = (u32x4){(unsigned)qw[4], (unsigned)qw[5], (unsigned)qw[6], (unsigned)qw[7]};
        }
    }
    const int NT = slen >> 6;
    const bool isk = wid < 4;
    const unsigned char* gsrc = (isk ? c.kf8 : c.gv8) + ((size_t)(s0 >> 6) * 4 + kvh) * 4096 + (wid & 3) * 1024 + lane * 16;
    const unsigned ldst = isk ? (unsigned)(G9_KOFF + (wid & 3) * 1040) : (unsigned)(G9_VOFF + (wid & 3) * 1024);
    const int tadd = isk ? 3 : 2;
#define DMA9(t, off) __builtin_amdgcn_global_load_lds((const unsigned*)(gsrc + (size_t)(t) * 16384), (LAS unsigned*)(lds + ldst + (off)), 16, 0, 0)
#define V8I(a, b) ((v8i_t){(int)(a).x, (int)(a).y, (int)(a).z, (int)(a).w, (int)(b).x, (int)(b).y, (int)(b).z, (int)(b).w})
#define V8P(W) ((v8i_t){W[0], W[1], W[2], W[3], W[4], W[5], W[6], W[7]})
#define FN9(...) asm volatile("" : __VA_ARGS__ : : "memory")
#define EXPG9(P, w, PW, idx) do { const float e0_ = __builtin_amdgcn_exp2f(P[4 * (w)]), e1_ = __builtin_amdgcn_exp2f(P[4 * (w) + 1]), e2_ = __builtin_amdgcn_exp2f(P[4 * (w) + 2]), e3_ = __builtin_amdgcn_exp2f(P[4 * (w) + 3]); \
        int pk_ = PW[idx]; pk_ = __builtin_amdgcn_cvt_pk_bf8_f32(e0_, e1_, pk_, false); pk_ = __builtin_amdgcn_cvt_pk_bf8_f32(e2_, e3_, pk_, true); PW[idx] = pk_; } while (0)
#define MSUM9(ACC, PWX) ACC = __builtin_amdgcn_mfma_scale_f32_16x16x128_f8f6f4(V8P(PWX), onesB, ACC, 1, 0, 0, 0, 0, 0)
    float zf = 0.f; asm volatile("" : "+v"(zf));
    f32x4 lacc[3]; f32x16 o[3][2];
#pragma unroll
    for (int hh = 0; hh < 3; ++hh) lacc[hh] = (f32x4){zf, zf, zf, zf};
    v8i_t onesB;
    { int ov = (((lane & 15) == 0 && ((lane >> 4) & 1) == 0) || ((lane & 15) == 1 && ((lane >> 4) & 1) == 1)) ? 0x38383838 : 0; asm volatile("" : "+v"(ov));
#pragma unroll
      for (int w = 0; w < 8; ++w) onesB[w] = ov; }
#pragma unroll
    for (int hh = 0; hh < 3; ++hh)
#pragma unroll
        for (int r = 0; r < 16; ++r) { o[hh][0][r] = zf; o[hh][1][r] = zf; }
    const LAS unsigned char* kp0 = Kl + (2 * hi) * 1040 + r32 * 16;
    const int vsw = (r32 >> 2) & 3;
    const LAS unsigned char* vpa0 = Vl + r32 * 64 + (((2 * hi) ^ vsw) << 4);
    const LAS unsigned char* vpb0 = Vl + r32 * 64 + (((2 * hi + 1) ^ vsw) << 4);
    LAS unsigned char* Qr = Qs;
    { const unsigned z_ = __float_as_uint(zf); if (tid < 256) *(LAS u32x4*)(Vl + 3 * G9_VB + tid * 16) = (u32x4){z_, z_, z_, z_}; }
    DMA9(0, 0); DMA9(isk ? 1 : 0, isk ? G9_KB : 0); DMA9(isk ? 2 : 1, isk ? 2 * G9_KB : G9_VB);
    asm volatile("s_waitcnt vmcnt(1)" ::: "memory"); LDS_WAIT();
    __syncthreads();
    f32x16 pa0, pa1, pb0, pb1; int pwA[8], pwB[8];
#pragma unroll
    for (int w = 0; w < 8; ++w) { pwA[w] = __float_as_int(zf); pwB[w] = __float_as_int(zf); }
    { const u32x4 a0 = *(const LAS u32x4*)(kp0), a1 = *(const LAS u32x4*)(kp0 + 1040), b0 = *(const LAS u32x4*)(kp0 + 512), b1 = *(const LAS u32x4*)(kp0 + 1552);
      const u32x4 q0_ = *(const LAS u32x4*)(Qr), q1_ = *(const LAS u32x4*)(Qr + 1024);
      pa0 = __builtin_amdgcn_mfma_scale_f32_32x32x64_f8f6f4(V8I(a0, a1), V8I(q0_, q1_), (f32x16){}, 0, 0, 0, 0x7f7f7f7f, 0, 0x7c7c7c7c);
      pa1 = __builtin_amdgcn_mfma_scale_f32_32x32x64_f8f6f4(V8I(b0, b1), V8I(q0_, q1_), (f32x16){}, 0, 0, 0, 0x7f7f7f7f, 0, 0x7c7c7c7c); }
#define STEP9(P0, P1, N0, N1, PWP, PW, H, HP, VS, KS, HN, FIRST, LAST, J) do { \
        const LAS unsigned char* kp = kp0 + (KS) * G9_KB; const LAS unsigned char* vpa = vpa0 + (VS) * G9_VB; const LAS unsigned char* vpb = vpb0 + (VS) * G9_VB; \
        u32x4 c0 = *(const LAS u32x4*)(vpa), c1 = *(const LAS u32x4*)(vpb), d0_ = *(const LAS u32x4*)(vpa + 2048), d1_ = *(const LAS u32x4*)(vpb + 2048); \
        u32x4 ka0 = *(const LAS u32x4*)(kp), ka1 = *(const LAS u32x4*)(kp + 1040), qa0 = *(const LAS u32x4*)(Qr + (HN) * 2048), qa1 = *(const LAS u32x4*)(Qr + (HN) * 2048 + 1024); \
        u32x4 kb0 = *(const LAS u32x4*)(kp + 512), kb1 = *(const LAS u32x4*)(kp + 1552); \
        if (FIRST) { const int jt = (J) + tadd < NT ? (J) + tadd : NT - 1; DMA9(jt, isk ? (((J) + 3) & 3) * G9_KB : (((J) + 2) & 3) * G9_VB); } \
        FN9("+v"(P0)); \
        EXPG9(P0, 0, PW, 0); \
        FN9("+v"(c0), "+v"(c1), "+v"(o[HP][0]), "+v"(PW[0]), "+v"(P0)); \
        o[HP][0] = __builtin_amdgcn_mfma_scale_f32_32x32x64_f8f6f4(V8P(PWP), V8I(c0, c1), o[HP][0], 1, 0, 0, 0, 0, 0); EXPG9(P0, 1, PW, 1); \
        FN9("+v"(d0_), "+v"(d1_), "+v"(o[HP][1]), "+v"(PW[1]), "+v"(P0)); \
        o[HP][1] = __builtin_amdgcn_mfma_scale_f32_32x32x64_f8f6f4(V8P(PWP), V8I(d0_, d1_), o[HP][1], 1, 0, 0, 0, 0, 0); EXPG9(P0, 2, PW, 2); \
        FN9("+v"(PW[2]), "+v"(lacc[HP]), "+v"(P0)); \
        MSUM9(lacc[HP], PWP); EXPG9(P0, 3, PW, 3); \
        FN9("+v"(ka0), "+v"(ka1), "+v"(PW[3]), "+v"(P1)); \
        N0 = __builtin_amdgcn_mfma_scale_f32_32x32x64_f8f6f4(V8I(ka0, ka1), V8I(qa0, qa1), (f32x16){}, 0, 0, 0, 0x7f7f7f7f, 0, 0x7c7c7c7c); EXPG9(P1, 0, PW, 4); \
        FN9("+v"(PW[4]), "+v"(P1)); \
        EXPG9(P1, 1, PW, 5); \
        FN9("+v"(kb0), "+v"(kb1), "+v"(PW[5]), "+v"(P1)); \
        N1 = __builtin_amdgcn_mfma_scale_f32_32x32x64_f8f6f4(V8I(kb0, kb1), V8I(qa0, qa1), (f32x16){}, 0, 0, 0, 0x7f7f7f7f, 0, 0x7c7c7c7c); EXPG9(P1, 2, PW, 6); \
        FN9("+v"(PW[6]), "+v"(P1), "+v"(N0)); \
        EXPG9(P1, 3, PW, 7); \
        FN9("+v"(PW[7])); \
        if (LAST) { asm volatile("s_waitcnt vmcnt(1) lgkmcnt(0)" ::: "memory"); __builtin_amdgcn_s_barrier(); asm volatile("" ::: "memory"); } \
    } while (0)
#pragma nounroll
    for (int j = 0; j < NT; j += 2) {
        STEP9(pa0, pa1, pb0, pb1, pwA, pwB, 0, 2, (j + 3) & 3, j & 3, 1, true, false, j);
        STEP9(pb0, pb1, pa0, pa1, pwB, pwA, 1, 0, j & 3, j & 3, 2, false, false, j);
        STEP9(pa0, pa1, pb0, pb1, pwA, pwB, 2, 1, j & 3, (j + 1) & 3, 0, false, true, j);
        STEP9(pb0, pb1, pa0, pa1, pwB, pwA, 0, 2, j & 3, (j + 1) & 3, 1, true, false, j + 1);
        STEP9(pa0, pa1, pb0, pb1, pwA, pwB, 1, 0, (j + 1) & 3, (j + 1) & 3, 2, false, false, j + 1);
        STEP9(pb0, pb1, pa0, pa1, pwB, pwA, 2, 1, (j + 1) & 3, (j + 2) & 3, 0, false, true, j + 1);
    }
    { const LAS unsigned char* vpa = vpa0 + ((NT - 1) & 3) * G9_VB; const LAS unsigned char* vpb = vpb0 + ((NT - 1) & 3) * G9_VB;
      const u32x4 c0 = *(const LAS u32x4*)(vpa), c1 = *(const LAS u32x4*)(vpb), d0_ = *(const LAS u32x4*)(vpa + 2048), d1_ = *(const LAS u32x4*)(vpb + 2048);
      o[2][0] = __builtin_amdgcn_mfma_scale_f32_32x32x64_f8f6f4(V8P(pwA), V8I(c0, c1), o[2][0], 1, 0, 0, 0, 0, 0);
      o[2][1] = __builtin_amdgcn_mfma_scale_f32_32x32x64_f8f6f4(V8P(pwA), V8I(d0_, d1_), o[2][1], 1, 0, 0, 0, 0, 0);
      MSUM9(lacc[2], pwA); }
    LDS_WAIT();
#undef DMA9
#undef V8I
#undef V8P
#undef FN9
#undef EXPG9
#undef STEP9
#undef MSUM9
    int le = lane; asm volatile("" : "+v"(le));
    bf16_t* ob = c.proj + (size_t)(s0 + qb * 256 + wid * 32) * LDP;
    LAS float* S = (LAS float*)(lds + G9_QOFF + 8 * 6144 + wid * EPI_WAVE_BYTES);
    auto rowoff = [&](int row) { return (size_t)row * LDP; };
#pragma unroll
    for (int hh = 0; hh < 3; ++hh) {
        if ((le & 15) < 2) *(LAS f32x4*)(wsf + 16 * (le & 15) + 4 * (le >> 4)) = lacc[hh];
        LDS_WAIT();
        const int ocol = C_GQ + (kvh * 3 + hh) * 64, gcol = C_GQG + (kvh * 3 + hh) * 64;
#pragma unroll
        for (int d0 = 0; d0 < 2; ++d0) epi_block(S, o[hh][d0], wsf, le, ob + gcol + d0 * 32, ob + ocol + d0 * 32, rowoff, DRY);
        LDS_WAIT();
    }
    __syncthreads();
}


constexpr int M9_NR = 4;
constexpr int M9_KB = 12 * 1040 + 64, M9_VB = 8192, M9_KOFF = 0, M9_VOFF = M9_NR * M9_KB, M9_WSOFF = M9_VOFF + M9_NR * M9_VB, M9_QOFF = 0;
static_assert(M9_WSOFF + 2048 + 8 * EPI_WAVE_BYTES <= RING_BYTES && 8 * 6144 <= M9_WSOFF && M9_KB % 16 == 0, "mla9 LDS map");
__device__ __forceinline__ void mla9_unit(const Ctx& c, int s0, int slen, int h, int qb, LAS unsigned char* lds, const bool DRY) {
    const int tid = opaque_tid(), lane = tid & 63, r32 = lane & 31, hi = lane >> 5;
    const int wid = __builtin_amdgcn_readfirstlane(tid >> 6);
    LAS unsigned char* Kl = lds + M9_KOFF; LAS unsigned char* Vl = lds + M9_VOFF;
    LAS float* wsf = (LAS float*)(lds + M9_WSOFF) + wid * 64;
    LAS unsigned char* Qs = lds + M9_QOFF + wid * 6144 + lane * 16;
    const int tq = qb * 256 + wid * 32 + r32;
    const size_t Rq = (size_t)(s0 + tq);
    const int NT = slen >> 6;
    {
        const bf16_t* qp = c.q + Rq * LDQ + h * 192;
#pragma nounroll
        for (int b = 0; b < 2; ++b) {
            bf16x8 raw[4];
#pragma unroll
            for (int d = 0; d < 4; ++d) raw[d] = *(const bf16x8*)(qp + b * 64 + hi * 32 + d * 8);
            int qw[8];
#pragma unroll
            for (int w = 0; w < 8; ++w) { int pk = 0; pk = __builtin_amdgcn_cvt_pk_fp8_f32(bf2f(raw[w >> 1][(w & 1) * 4]) * 8.f, bf2f(raw[w >> 1][(w & 1) * 4 + 1]) * 8.f, pk, false);
                pk = __builtin_amdgcn_cvt_pk_fp8_f32(bf2f(raw[w >> 1][(w & 1) * 4 + 2]) * 8.f, bf2f(raw[w >> 1][(w & 1) * 4 + 3]) * 8.f, pk, true); qw[w] = pk; }
            *(LAS u32x4*)(Qs + (b * 2) * 1024) = (u32x4){(unsigned)qw[0], (unsigned)qw[1], (unsigned)qw[2], (unsigned)qw[3]};
            *(LAS u32x4*)(Qs + (b * 2 + 1) * 1024) = (u32x4){(unsigned)qw[4], (unsigned)qw[5], (unsigned)qw[6], (unsigned)qw[7]};
        }
        {
            bf16x8 ra[2], rb[2];
#pragma unroll
            for (int d = 0; d < 2; ++d) { ra[d] = *(const bf16x8*)(qp + 128 + hi * 16 + d * 8); rb[d] = *(const bf16x8*)(qp + 128 + 32 + hi * 16 + d * 8); }
            const f32x2* tb = c.ropeT + (size_t)tq * 32 + hi * 16;
            int qa[4], qb_[4];
#pragma unroll
            for (int w = 0; w < 4; ++w) { float y1[4], y2[4];
#pragma unroll
                for (int t = 0; t < 4; ++t) { const int e = 4 * w + t; const f32x2 cs = tb[e]; const float x1 = bf2f(ra[e >> 3][e & 7]) * 8.f, x2 = bf2f(rb[e >> 3][e & 7]) * 8.f;
                    y1[t] = x1 * cs.x - x2 * cs.y; y2[t] = x2 * cs.x + x1 * cs.y; }
                int pa_ = 0, pb_ = 0;
                pa_ = __builtin_amdgcn_cvt_pk_fp8_f32(y1[0], y1[1], pa_, false); pa_ = __builtin_amdgcn_cvt_pk_fp8_f32(y1[2], y1[3], pa_, true);
                pb_ = __builtin_amdgcn_cvt_pk_fp8_f32(y2[0], y2[1], pb_, false); pb_ = __builtin_amdgcn_cvt_pk_fp8_f32(y2[2], y2[3], pb_, true);
                qa[w] = pa_; qb_[w] = pb_; }
            *(LAS u32x4*)(Qs + 4 * 1024) = (u32x4){(unsigned)qa[0], (unsigned)qa[1], (unsigned)qa[2], (unsigned)qa[3]};
            *(LAS u32x4*)(Qs + 5 * 1024) = (u32x4){(unsigned)qb_[0], (unsigned)qb_[1], (unsigned)qb_[2], (unsigned)qb_[3]};
        }
    }
    const size_t T0 = (size_t)(s0 >> 6);
    const unsigned char* gkn = c.kn8 + (T0 * 6 + h) * 8192 + wid * 1024 + lane * 16;
    const unsigned char* gv = c.v8 + (T0 * 6 + h) * 8192 + wid * 1024 + lane * 16;
    const unsigned char* gkr = c.kr8 + T0 * 4096 + (wid & 3) * 1024 + lane * 16;
    const unsigned lkn = (unsigned)(M9_KOFF + wid * 1040), lkr = (unsigned)(M9_KOFF + (8 + (wid & 3)) * 1040), lv = (unsigned)(M9_VOFF + wid * 1024);
#define DMAK9(t, ring) do { __builtin_amdgcn_global_load_lds((const unsigned*)(gkn + (size_t)(t) * 49152), (LAS unsigned*)(lds + lkn + (ring) * M9_KB), 16, 0, 0); \
        __builtin_amdgcn_global_load_lds((const unsigned*)(gkr + (size_t)(t) * 4096), (LAS unsigned*)(lds + lkr + (ring) * M9_KB), 16, 0, 0); } while (0)
#define DMAV9(t, ring) __builtin_amdgcn_global_load_lds((const unsigned*)(gv + (size_t)(t) * 49152), (LAS unsigned*)(lds + lv + (ring) * M9_VB), 16, 0, 0)
#define SB9 __builtin_amdgcn_sched_barrier(0)
#define V8I(a, b) ((v8i_t){(int)(a).x, (int)(a).y, (int)(a).z, (int)(a).w, (int)(b).x, (int)(b).y, (int)(b).z, (int)(b).w})
#define RDKA9(D0, D1, blk) do { D0 = *(const LAS u32x4*)(kp + (blk) * 4160); D1 = *(const LAS u32x4*)(kp + (blk) * 4160 + 1040); } while (0)
#define RDKB9(D0, D1, blk) do { D0 = *(const LAS u32x4*)(kp + (blk) * 4160 + 512); D1 = *(const LAS u32x4*)(kp + (blk) * 4160 + 1552); } while (0)
#define RDQ9(D0, D1, blk) do { D0 = qr[2 * (blk)]; D1 = qr[2 * (blk) + 1]; } while (0)
#define RDV9(D0, D1, d0) do { D0 = *(const LAS u32x4*)(vpa + (d0) * 2048); D1 = *(const LAS u32x4*)(vpb + (d0) * 2048); } while (0)
#define MQK9(ACC, K0, K1, Q0, Q1, CIN) ACC = __builtin_amdgcn_mfma_scale_f32_32x32x64_f8f6f4(V8I(K0, K1), V8I(Q0, Q1), CIN, 0, 0, 0, 0x7f7f7f7f, 0, 0x7c7c7c7c)
#define V8P(W) ((v8i_t){W[0], W[1], W[2], W[3], W[4], W[5], W[6], W[7]})
#define MPV9(d0, V0, V1, PWP) o[d0] = __builtin_amdgcn_mfma_scale_f32_32x32x64_f8f6f4(PWP, V8I(V0, V1), o[d0], 0, 0, 0, 0, 0, 0)
#define EXPG9(P, w, PW, idx, SUB) do { float e0_ = P[4 * (w)], e1_ = P[4 * (w) + 1], e2_ = P[4 * (w) + 2], e3_ = P[4 * (w) + 3]; \
        if (SUB) { e0_ -= mhat; e1_ -= mhat; e2_ -= mhat; e3_ -= mhat; } \
        e0_ = __builtin_amdgcn_exp2f(e0_); e1_ = __builtin_amdgcn_exp2f(e1_); e2_ = __builtin_amdgcn_exp2f(e2_); e3_ = __builtin_amdgcn_exp2f(e3_); \
        int pk_ = PW[idx]; pk_ = __builtin_amdgcn_cvt_pk_fp8_f32(e0_, e1_, pk_, false); pk_ = __builtin_amdgcn_cvt_pk_fp8_f32(e2_, e3_, pk_, true); PW[idx] = pk_; } while (0)
    float zf = 0.f; asm volatile("" : "+v"(zf));
    float mhat = zf; f32x4 lacc = {zf, zf, zf, zf}; f32x16 o[4];
    v8i_t onesB;
    { int ov = (((lane & 15) == 0 && ((lane >> 4) & 1) == 0) || ((lane & 15) == 1 && ((lane >> 4) & 1) == 1)) ? 0x38383838 : 0; asm volatile("" : "+v"(ov));
#pragma unroll
      for (int w = 0; w < 8; ++w) onesB[w] = ov; }
#define MSUM9(PWX) lacc = __builtin_amdgcn_mfma_scale_f32_16x16x128_f8f6f4(V8P(PWX), onesB, lacc, 0, 0, 0, 0, 0, 0)
#pragma unroll
    for (int d = 0; d < 4; ++d)
#pragma unroll
        for (int r = 0; r < 16; ++r) o[d][r] = zf;
    u32x4 qr[6];
    LDS_WAIT();
#pragma unroll
    for (int i = 0; i < 6; ++i) qr[i] = *(const LAS u32x4*)(Qs + i * 1024);
    LDS_WAIT(); __syncthreads();
    const LAS unsigned char* kp0 = Kl + (2 * hi) * 1040 + r32 * 16;
    const int vsw = (r32 >> 2) & 3;
    const LAS unsigned char* vpa0 = Vl + r32 * 64 + (((2 * hi) ^ vsw) << 4);
    const LAS unsigned char* vpb0 = Vl + r32 * 64 + (((2 * hi + 1) ^ vsw) << 4);
    { const unsigned z_ = __float_as_uint(zf); for (int i = tid * 16; i < M9_VB; i += 8192) *(LAS u32x4*)(Vl + 3 * M9_VB + i) = (u32x4){z_, z_, z_, z_}; }
    DMAK9(0, 0); DMAK9(1, 1);
    DMAK9(2, 2); DMAV9(0, 0);
    DMAK9(3, 3); DMAV9(1, 1);
    asm volatile("s_waitcnt vmcnt(6)" ::: "memory"); LDS_WAIT();
    __syncthreads();
    f32x16 pa0, pa1, pb0, pb1; int pwA[8], pwB[8];
#pragma unroll
    for (int w = 0; w < 8; ++w) { pwA[w] = __float_as_int(zf); pwB[w] = __float_as_int(zf); }
    { const LAS unsigned char* kp = kp0;
#pragma unroll
      for (int blk = 0; blk < 3; ++blk) { u32x4 a0, a1, b0, b1, q0_, q1_; RDKA9(a0, a1, blk); RDKB9(b0, b1, blk); RDQ9(q0_, q1_, blk);
          if (blk == 0) { MQK9(pa0, a0, a1, q0_, q1_, (f32x16){}); MQK9(pa1, b0, b1, q0_, q1_, (f32x16){}); } else { MQK9(pa0, a0, a1, q0_, q1_, pa0); MQK9(pa1, b0, b1, q0_, q1_, pa1); } } }
    LDS_WAIT();
    __syncthreads();
    int kro = M9_KB, vro = 3 * M9_VB, dko = 0, dvo = 2 * M9_VB;
#define FN9(...) asm volatile("" : __VA_ARGS__ : : "memory")
#define REST9(P0, P1, N0, N1, PWP, PW, J, SUB) do { \
        u32x4 c0, c1, d0_, d1_, g0, g1, t0_, t1_; \
        FN9("+v"(ka0), "+v"(ka1), "+v"(P0)); \
        MQK9(N0, ka0, ka1, qa0, qa1, (f32x16){}); RDKA9(c0, c1, 1); RDQ9(g0, g1, 1); EXPG9(P0, 0, PW, 0, SUB); \
        FN9("+v"(kb0), "+v"(kb1), "+v"(PW[0]), "+v"(P0)); \
        MQK9(N1, kb0, kb1, qa0, qa1, (f32x16){}); RDKB9(d0_, d1_, 1); EXPG9(P0, 1, PW, 1, SUB); \
        FN9("+v"(c0), "+v"(c1), "+v"(N0), "+v"(PW[1]), "+v"(P0)); \
        MQK9(N0, c0, c1, g0, g1, N0); RDKA9(ka0, ka1, 2); RDQ9(qa0, qa1, 2); EXPG9(P0, 2, PW, 2, SUB); \
        FN9("+v"(d0_), "+v"(d1_), "+v"(N1), "+v"(PW[2]), "+v"(P0)); \
        MQK9(N1, d0_, d1_, g0, g1, N1); RDKB9(kb0, kb1, 2); EXPG9(P0, 3, PW, 3, SUB); \
        FN9("+v"(ka0), "+v"(ka1), "+v"(N0), "+v"(PW[3]), "+v"(P1)); \
        MQK9(N0, ka0, ka1, qa0, qa1, N0); RDV9(c0, c1, 0); EXPG9(P1, 0, PW, 4, SUB); \
        FN9("+v"(kb0), "+v"(kb1), "+v"(N1), "+v"(PW[4]), "+v"(P1)); \
        MQK9(N1, kb0, kb1, qa0, qa1, N1); RDV9(d0_, d1_, 1); EXPG9(P1, 1, PW, 5, SUB); \
        FN9("+v"(c0), "+v"(c1), "+v"(o[0]), "+v"(PW[5]), "+v"(P1)); \
        MPV9(0, c0, c1, V8P(PWP)); RDV9(g0, g1, 2); EXPG9(P1, 2, PW, 6, SUB); \
        FN9("+v"(d0_), "+v"(d1_), "+v"(o[1]), "+v"(PW[6]), "+v"(P1)); \
        MPV9(1, d0_, d1_, V8P(PWP)); RDV9(t0_, t1_, 3); EXPG9(P1, 3, PW, 7, SUB); \
        FN9("+v"(g0), "+v"(g1), "+v"(o[2]), "+v"(PW[7])); \
        MPV9(2, g0, g1, V8P(PWP)); \
        FN9("+v"(t0_), "+v"(t1_), "+v"(o[3]), "+v"(lacc)); \
        MSUM9(PWP); \
        MPV9(3, t0_, t1_, V8P(PWP)); { const int jk = (J) + 4 < NT ? (J) + 4 : NT - 1, jv = (J) + 2 < NT ? (J) + 2 : NT - 1; \
            __builtin_amdgcn_global_load_lds((const unsigned*)(gkn + (size_t)jk * 49152), (LAS unsigned*)(lds + lkn + dko), 16, 0, 0); \
            __builtin_amdgcn_global_load_lds((const unsigned*)(gkr + (size_t)jk * 4096), (LAS unsigned*)(lds + lkr + dko), 16, 0, 0); \
            __builtin_amdgcn_global_load_lds((const unsigned*)(gv + (size_t)jv * 49152), (LAS unsigned*)(lds + lv + dvo), 16, 0, 0); } \
        FN9("+v"(N0), "+v"(N1), "+v"(o[0]), "+v"(o[1])); \
    } while (0)
#define BODY9(P0, P1, N0, N1, PWP, PW, J) do { \
        const LAS unsigned char* kp = kp0 + kro; const LAS unsigned char* vpa = vpa0 + vro; const LAS unsigned char* vpb = vpb0 + vro; \
        u32x4 ka0, ka1, kb0, kb1, qa0, qa1; \
        RDKA9(ka0, ka1, 0); RDQ9(qa0, qa1, 0); RDKB9(kb0, kb1, 0); \
        float a_ = fmaxf(fmaxf(P0[0], P0[1]), P1[0]), b_ = fmaxf(fmaxf(P0[2], P0[3]), P1[1]); a_ = fmaxf(fmaxf(a_, P1[2]), P1[3]); \
        _Pragma("unroll") for (int r = 4; r < 16; r += 4) { a_ = fmaxf(fmaxf(a_, P0[r]), P0[r + 1]); b_ = fmaxf(fmaxf(b_, P0[r + 2]), P0[r + 3]); a_ = fmaxf(fmaxf(a_, P1[r]), P1[r + 1]); b_ = fmaxf(fmaxf(b_, P1[r + 2]), P1[r + 3]); } \
        float rm = fmaxf(a_, b_); rm = fmaxf(rm, part32(rm)); \
        float alpha = 1.f; const bool first = ((J) == 0); \
        const bool okl = first ? (rm <= THR2 && rm >= -4.f) : (rm - mhat <= THR2);     \
        if (__builtin_expect(!__all(okl), 0)) { const float mn = first ? rm : fmaxf(mhat, rm); alpha = first ? 1.f : __builtin_amdgcn_exp2f(mhat - mn); mhat = mn; } \
        if (__builtin_expect(__any(mhat != 0.f), 0)) { _Pragma("unroll") for (int r = 0; r < 16; ++r) { P0[r] -= mhat; P1[r] -= mhat; } } \
        REST9(P0, P1, N0, N1, PWP, PW, J, false); \
        if (__builtin_expect(__any(alpha < 1.f), 0)) { if (hi == 0) wsf[r32] = alpha; LDS_WAIT(); \
            _Pragma("unroll") for (int d = 0; d < 4; ++d) _Pragma("unroll") for (int r = 0; r < 16; ++r) o[d][r] *= wsf[crow(r, hi)]; \
            lacc *= *(const LAS f32x4*)(wsf + 16 * (lane & 1) + 4 * (lane >> 4)); LDS_WAIT(); } \
        { const int t_ = kro + M9_KB; kro = t_ == M9_NR * M9_KB ? 0 : t_; const int u_ = vro + M9_VB; vro = u_ == M9_NR * M9_VB ? 0 : u_; \
          const int v_ = dko + M9_KB; dko = v_ == M9_NR * M9_KB ? 0 : v_; const int w_ = dvo + M9_VB; dvo = w_ == M9_NR * M9_VB ? 0 : w_; } \
        asm volatile("s_waitcnt vmcnt(6) lgkmcnt(0)" ::: "memory"); __builtin_amdgcn_s_barrier(); asm volatile("" ::: "memory"); \
    } while (0)
#pragma nounroll
    for (int j = 0; j < NT; j += 2) {
        BODY9(pa0, pa1, pb0, pb1, pwA, pwB, j);
        BODY9(pb0, pb1, pa0, pa1, pwB, pwA, j + 1);
    }
    { const LAS unsigned char* vpa = vpa0 + vro; const LAS unsigned char* vpb = vpb0 + vro; u32x4 c0, c1, d0_, d1_, g0, g1, t0_, t1_;
      RDV9(c0, c1, 0); RDV9(d0_, d1_, 1); RDV9(g0, g1, 2); RDV9(t0_, t1_, 3);
      MPV9(0, c0, c1, V8P(pwA)); MPV9(1, d0_, d1_, V8P(pwA)); MPV9(2, g0, g1, V8P(pwA)); MPV9(3, t0_, t1_, V8P(pwA)); MSUM9(pwA); }
    VM_WAIT();
#undef DMAK9
#undef DMAV9
#undef SB9
#undef V8I
#undef RDKA9
#undef RDKB9
#undef RDQ9
#undef RDV9
#undef MQK9
#undef MPV9
#undef EXPG9
#undef REST9
#undef BODY9
#undef MSUM9
#undef FN9
#undef V8P
    LDS_WAIT(); if ((lane & 15) < 2) *(LAS f32x4*)(wsf + 32 + 16 * (lane & 15) + 4 * (lane >> 4)) = lacc; LDS_WAIT();
    { int le = lane; asm volatile("" : "+v"(le));
      bf16_t* ob = c.proj + (size_t)(s0 + qb * 256 + wid * 32) * LDP + C_MLAG + h * 128;
      LAS float* S = (LAS float*)(lds + M9_WSOFF + 2048 + wid * EPI_WAVE_BYTES);
      auto rowoff = [&](int row) { return (size_t)row * LDP; };
#pragma unroll
      for (int d0 = 0; d0 < 4; ++d0) epi_block(S, o[d0], wsf + 32, le, ob + d0 * 32, ob + d0 * 32, rowoff, DRY); }
    LDS_WAIT();
    __syncthreads();
}


template <int KIND> __device__ __forceinline__ void attn_unit(const Ctx& c, int s0, int slen, int h, int qb, LAS unsigned char* lds, const bool DRY) {
    constexpr int NDQ = Cfg<KIND>::NDQ, NDV = Cfg<KIND>::NDV, KB = 2 * NDQ * 1040, VB = NDV * 4096;
    constexpr float SC = Cfg<KIND>::SCALE;
    const int tid = opaque_tid(), lane = tid & 63, r32 = lane & 31, hi = lane >> 5;
    const int wid = __builtin_amdgcn_readfirstlane(tid >> 6);
    LAS unsigned char* Kl = lds + A_KOFF; LAS unsigned char* Vl = lds + A_VOFF;
    LAS float* wsf = (LAS float*)(lds + A_WSOFF) + wid * 64;
    LAS float* bl = (LAS float*)(lds + A_BOFF);
    const int tq = qb * 256 + wid * 32 + r32;
    const size_t Rq = (size_t)(s0 + tq);
    int NT, kt0; int rsw = 0, rq = 0, cq = 0, csq = 0;
    if (KIND == 2) {
        const int rows = slen >> 6, r0 = qb * 4;
        const int lo = min(max(r0 - 4, 0), rows - 8), hi_r = min(max(r0 + 3 - 4, 0), rows - 8) + 7;
        NT = hi_r - lo + 1; kt0 = lo * 64;
        rq = r0 + (wid >> 1); rsw = min(max(rq - 4, 0), rows - 8);
        cq = 32 * (wid & 1) + r32; csq = min(max(cq - 8, 0), 48);
        for (int i = tid; i < 15 * 32; i += 512) { const int di = i >> 5, dj = i & 31; bl[i] = (dj < 31) ? c.rpb[(h * 15 + di) * 31 + dj] * (1.0f / SC) : 0.f; }
    } else { NT = slen >> 6; kt0 = 0; }
    bf16x8 qr[NDQ];
    if (KIND == 0) {
        const bf16_t* qp = c.q + Rq * LDQ + h * 192 + hi * 8;
#pragma unroll
        for (int d0 = 0; d0 < 12; ++d0) qr[d0] = *(const bf16x8*)(qp + d0 * 16);
        const f32x2* tb = c.ropeT + (size_t)tq * 32 + hi * 8;
#pragma unroll
        for (int a = 0; a < 2; ++a) {
            unsigned w1[4], w2[4];
#pragma unroll
            for (int i = 0; i < 8; i += 2) {
                const f32x2 cs0 = tb[a * 16 + i], cs1 = tb[a * 16 + i + 1];
                const float x10 = bf2f(qr[8 + a][i]), x11 = bf2f(qr[8 + a][i + 1]), x20 = bf2f(qr[10 + a][i]), x21 = bf2f(qr[10 + a][i + 1]);
                w1[i >> 1] = cvt_pk_bf16(x10 * cs0.x - x20 * cs0.y, x11 * cs1.x - x21 * cs1.y);
                w2[i >> 1] = cvt_pk_bf16(x20 * cs0.x + x10 * cs0.y, x21 * cs1.x + x11 * cs1.y);
            }
            qr[8 + a] = __builtin_bit_cast(bf16x8, (u32x4){w1[0], w1[1], w1[2], w1[3]});
            qr[10 + a] = __builtin_bit_cast(bf16x8, (u32x4){w2[0], w2[1], w2[2], w2[3]});
        }
    } else if (KIND == 1) {
        const bf16_t* qp = c.proj + Rq * LDP + C_GQ + h * 64 + hi * 8;
        float x[4][8]; float ss = 0.f;
#pragma unroll
        for (int d0 = 0; d0 < 4; ++d0) { const bf16x8 v = *(const bf16x8*)(qp + d0 * 16);
#pragma unroll
            for (int i = 0; i < 8; ++i) { x[d0][i] = bf2f(v[i]); ss += x[d0][i] * x[d0][i]; } }
        ss += part32(ss);
        const float rstd = 1.0f / sqrtf(ss * (1.0f / 64.0f) + EPS);
#pragma unroll
        for (int d0 = 0; d0 < 4; ++d0)
#pragma unroll
            for (int i = 0; i < 8; ++i) x[d0][i] *= rstd * c.gq_norm[d0 * 16 + hi * 8 + i];
        const f32x2* tr = c.rowT + (tq >> 6) * 16 + hi * 8; const f32x2* tc = c.colT + (tq & 63) * 16 + hi * 8;
#pragma unroll
        for (int a = 0; a < 2; ++a) {
            unsigned w1[4], w2[4];
#pragma unroll
            for (int i = 0; i < 8; i += 2) {
                const f32x2 cs0 = a ? tc[i] : tr[i], cs1 = a ? tc[i + 1] : tr[i + 1];
                const float x10 = x[2 * a][i], x11 = x[2 * a][i + 1], x20 = x[2 * a + 1][i], x21 = x[2 * a + 1][i + 1];
                w1[i >> 1] = cvt_pk_bf16(x10 * cs0.x - x20 * cs0.y, x11 * cs1.x - x21 * cs1.y);
                w2[i >> 1] = cvt_pk_bf16(x20 * cs0.x + x10 * cs0.y, x21 * cs1.x + x11 * cs1.y);
            }
            qr[2 * a] = __builtin_bit_cast(bf16x8, (u32x4){w1[0], w1[1], w1[2], w1[3]});
            qr[2 * a + 1] = __builtin_bit_cast(bf16x8, (u32x4){w2[0], w2[1], w2[2], w2[3]});
        }
    } else {
        const bf16_t* qp = c.proj + Rq * LDP + C_NAQ + h * 64 + hi * 8;
#pragma unroll
        for (int d0 = 0; d0 < 4; ++d0) qr[d0] = *(const bf16x8*)(qp + d0 * 16);
    }
    const size_t krow0 = (size_t)(s0 + kt0);
    const bf16_t *gk0, *gk1 = nullptr, *gk2 = nullptr, *gv0, *gv1 = nullptr;
    int lk0, lk1 = 0, lk2 = 0, lv0, lv1 = 0; size_t kstride, vstride, k2stride = 0;
    if (KIND == 0) {
        const int ka = tid >> 4, ca = tid & 15, kb2 = 32 + ka;
        gk0 = c.kv + (krow0 + ka) * LDKV + h * 256 + ca * 8; gk1 = c.kv + (krow0 + kb2) * LDKV + h * 256 + ca * 8; kstride = (size_t)64 * LDKV;
        lk0 = ca * 1040 + ka * 16; lk1 = ca * 1040 + kb2 * 16;
        const int kr = tid >> 3, cr = tid & 7;
        gk2 = c.proj + (krow0 + kr) * LDP + C_KR + cr * 8; k2stride = (size_t)64 * LDP; lk2 = (16 + cr) * 1040 + kr * 16;
        gv0 = c.kv + (krow0 + ka) * LDKV + h * 256 + 128 + ca * 8; gv1 = c.kv + (krow0 + kb2) * LDKV + h * 256 + 128 + ca * 8; vstride = (size_t)64 * LDKV;
        lv0 = v_st<NDV>(ka, ca * 8); lv1 = v_st<NDV>(kb2, ca * 8);
    } else {
        const int kr = tid >> 3, cr = tid & 7;
        const int kcol = (KIND == 1) ? C_GK + (h / 3) * 64 : C_NAK + h * 64, vcol = (KIND == 1) ? C_GV + (h / 3) * 64 : C_NAV + h * 64;
        gk0 = c.proj + (krow0 + kr) * LDP + kcol + cr * 8; gv0 = c.proj + (krow0 + kr) * LDP + vcol + cr * 8; kstride = vstride = (size_t)64 * LDP;
        lk0 = cr * 1040 + kr * 16; lv0 = v_st<NDV>(kr, cr * 8);
    }
    bf16x8 sk0, sk1, sk2, sv0, sv1;
#define SLOAD(j) do { sk0 = *(const bf16x8*)(gk0 + (size_t)(j) * kstride); sv0 = *(const bf16x8*)(gv0 + (size_t)(j) * vstride); \
        if (KIND == 0) { sk1 = *(const bf16x8*)(gk1 + (size_t)(j) * kstride); sk2 = *(const bf16x8*)(gk2 + (size_t)(j) * k2stride); sv1 = *(const bf16x8*)(gv1 + (size_t)(j) * vstride); } } while (0)
#define SWRITE(b) do { *(LAS bf16x8*)(Kl + (b) * KB + lk0) = sk0; *(LAS bf16x8*)(Vl + (b) * VB + lv0) = sv0; \
        if (KIND == 0) { *(LAS bf16x8*)(Kl + (b) * KB + lk1) = sk1; *(LAS bf16x8*)(Kl + (b) * KB + lk2) = sk2; *(LAS bf16x8*)(Vl + (b) * VB + lv1) = sv1; } } while (0)
    float m_reg = (KIND == 0) ? 0.f : -1e30f, l_reg = 0.f; f32x16 o[NDV];
#pragma unroll
    for (int d = 0; d < NDV; ++d) o[d] = f32x16{};
    SLOAD(0); SWRITE(0); if (NT > 1) SLOAD(1);
    __syncthreads();
    const LAS unsigned char* vp0 = Vl + v_rd_base(lane);
    for (int j = 0; j < NT; ++j) {
        const int b = j & 1;
        bool act = true; int di = 0;
        if (KIND == 2) { const int kr = (kt0 >> 6) + j; act = (kr >= rsw) && (kr < rsw + 8); di = kr - rq + 7; }
        if (act) {
            f32x16 p0, p1; bf16x8 pa0, pa1, pa2, pa3; float alpha;
            qkt<NDQ>(p0, p1, Kl + b * KB, qr, r32, hi);
            if (j + 1 < NT) SWRITE(b ^ 1);
            if (j + 2 < NT) SLOAD(j + 2);
            const LAS unsigned char* vp = vp0 + b * VB;
            VF fa; v_read<NDV, 0>(fa, vp);
            if (KIND == 2) {
                const LAS float* br = bl + di * 32 + (15 - cq);
#pragma unroll
                for (int r = 0; r < 16; ++r) { const int k0_ = crow(r, hi), k1_ = 32 + k0_;
                    const bool v0 = (k0_ >= csq) && (k0_ < csq + 16), v1 = (k1_ >= csq) && (k1_ < csq + 16);
                    const float b0_ = br[v0 ? k0_ : cq], b1_ = br[v1 ? k1_ : cq];
                    p0[r] = v0 ? p0[r] + b0_ : -INFINITY; p1[r] = v1 ? p1[r] + b1_ : -INFINITY; }
            }
            if (KIND == 0) softmax_ref(p0, p1, m_reg, l_reg, alpha, j == 0, pa0, pa1, pa2, pa3); else softmax_tile<KIND>(p0, p1, m_reg, l_reg, alpha, pa0, pa1, pa2, pa3);
            if (__any(alpha < 1.f)) { if (hi == 0) wsf[r32] = alpha; LDS_WAIT();
#pragma unroll
                for (int d = 0; d < NDV; ++d)
#pragma unroll
                    for (int r = 0; r < 16; ++r) o[d][r] *= wsf[crow(r, hi)];
                LDS_WAIT(); }
            SBAR();
            VF fb; v_read<NDV, 1>(fb, vp); SBAR();
            pv_mma(o[0], fa, pa0, pa1, pa2, pa3); SBAR();
            if (NDV == 4) { v_read<NDV, 2>(fa, vp); SBAR(); pv_mma(o[1], fb, pa0, pa1, pa2, pa3); SBAR(); v_read<NDV, 3>(fb, vp); SBAR(); pv_mma(o[NDV - 2], fa, pa0, pa1, pa2, pa3); SBAR(); pv_mma(o[NDV - 1], fb, pa0, pa1, pa2, pa3); }
            else pv_mma(o[1], fb, pa0, pa1, pa2, pa3);
            SBAR();
        } else {
            if (j + 1 < NT) SWRITE(b ^ 1);
            if (j + 2 < NT) SLOAD(j + 2);
        }
        __syncthreads();
    }
#undef SLOAD
#undef SWRITE
    if (hi == 0) wsf[32 + r32] = l_reg; LDS_WAIT();
    const int ocol = (KIND == 0) ? C_MLAG + h * 128 : (KIND == 1) ? C_GQ + h * 64 : C_NAQ + h * 64;
    const int gcol = (KIND == 0) ? C_MLAG + h * 128 : (KIND == 1) ? C_GQG + h * 64 : C_NAG + h * 64;
    int r32e = r32; asm volatile("" : "+v"(r32e));
    bf16_t* obase = c.proj + (size_t)(s0 + qb * 256 + wid * 32) * LDP + r32e;
#pragma unroll
    for (int r = 0; r < 16; ++r) { const int orow = crow(r, hi); const float rl = __builtin_amdgcn_rcpf(wsf[32 + orow]);
#pragma unroll
        for (int d0 = 0; d0 < NDV; ++d0) { const float gt = bf2f((short)obase[(size_t)orow * LDP + gcol + d0 * 32]);
            const float y = o[d0][r] * rl * gt * __builtin_amdgcn_rcpf(1.f + __builtin_amdgcn_exp2f(-gt * LOG2E));
            if (!DRY) obase[(size_t)orow * LDP + ocol + d0 * 32] = (bf16_t)(cvt_pk_bf16(y, 0.f) & 0xffffu); } }
    LDS_WAIT();
    __syncthreads();
}
}

#define XB_TMO      128
#define XB_XCNT(j)  (256  + 64 * (j))
#define XB_XSUB(j)  (1280 + 64 * (j))
#define XB_XGEN(j)  (2304 + 64 * (j))
#define XB_TOP      3328
#define XB_TOPGEN   3392
#define XCD_BAR_WORDS 3456
#define XB_SPIN_CAP (1u << 20)
__device__ __forceinline__ unsigned xb_ld(unsigned* p)              { return __hip_atomic_load(p, __ATOMIC_RELAXED, __HIP_MEMORY_SCOPE_AGENT); }
__device__ __forceinline__ unsigned xb_add(unsigned* p, unsigned v) { return __hip_atomic_fetch_add(p, v, __ATOMIC_RELAXED, __HIP_MEMORY_SCOPE_AGENT); }
__device__ __forceinline__ unsigned xb_xcc_id() { return (unsigned)__builtin_amdgcn_s_getreg((3 << 11) | 20) & 0xFu; }
#define XB_SPIN(cond, bar) do { unsigned _sp = 0; while (cond) { __builtin_amdgcn_s_sleep(1); \
    if ((++_sp & 255u) == 0u) { if (xb_ld(&(bar)[XB_TMO])) break; if (_sp > XB_SPIN_CAP) { atomicAdd(&(bar)[XB_TMO], 1u); break; } } } } while (0)
struct XcdBarrier { unsigned* bar; unsigned x; volatile LAS unsigned* st; };
__device__ __forceinline__ XcdBarrier xcd_barrier_post(unsigned* bar, volatile LAS unsigned* st) {
    XcdBarrier b; b.bar = bar; b.x = xb_xcc_id(); b.st = st;
    if (threadIdx.x == 0) (void)xb_add(&bar[XB_XCNT(b.x)], 1u);
    return b;
}
__device__ __forceinline__ void xcd_barrier_complete(unsigned* bar, unsigned x, unsigned& nloc, unsigned& nx) {
    const unsigned G = gridDim.x * gridDim.y * gridDim.z;
    unsigned sum, cnt, mine, sp = 0u;
    for (;;) {
        sum = 0u; cnt = 0u; mine = 0u;
#pragma unroll
        for (unsigned j = 0; j < 16; ++j) { const unsigned c = xb_ld(&bar[XB_XCNT(j)]); sum += c; cnt += (c > 0u) ? 1u : 0u; mine = (j == x) ? c : mine; }
        if (sum == G) break;
        __builtin_amdgcn_s_sleep(1);
        if ((++sp & 255u) == 0u) { if (xb_ld(&bar[XB_TMO])) break; if (sp > XB_SPIN_CAP) { atomicAdd(&bar[XB_TMO], 1u); break; } }
    }
    nloc = mine > 0u ? mine : 1u; nx = cnt > 0u ? cnt : 1u;
}
__device__ __forceinline__ void xcd_barrier(const XcdBarrier& b) {
    asm volatile("s_waitcnt vmcnt(0)" ::: "memory");
    __syncthreads();
    if (threadIdx.x == 0) {
        unsigned* bar = b.bar;
        __builtin_amdgcn_s_waitcnt(0);
        unsigned nloc = b.st[0], nx = b.st[1];
        if (nloc == 0u) { xcd_barrier_complete(bar, b.x, nloc, nx); b.st[0] = nloc; b.st[1] = nx; }
        const unsigned old = xb_add(&bar[XB_XSUB(b.x)], 1u);
        const unsigned gen = old / nloc;
        if (old + 1u == (gen + 1u) * nloc) {
            __builtin_amdgcn_fence(__ATOMIC_RELEASE, "agent");
            asm volatile("s_waitcnt vmcnt(0)" ::: "memory");
            const unsigned og = xb_add(&bar[XB_TOP], 1u);
            const unsigned tg = og / nx;
            if (og + 1u == (tg + 1u) * nx) xb_add(&bar[XB_TOPGEN], 1u);
            else XB_SPIN(xb_ld(&bar[XB_TOPGEN]) == tg, bar);
            __builtin_amdgcn_fence(__ATOMIC_ACQUIRE, "agent");
            xb_add(&bar[XB_XGEN(b.x)], 1u);
            asm volatile("s_waitcnt vmcnt(0)" ::: "memory");
        } else {
            XB_SPIN(xb_ld(&bar[XB_XGEN(b.x)]) == gen, bar);
            __builtin_amdgcn_fence(__ATOMIC_ACQUIRE, "agent");
            asm volatile("s_waitcnt vmcnt(0)" ::: "memory");
        }
    }
    __syncthreads();
}

struct Args {
    const float* xp; const float* xs; const float* pp; const float* ps; const float* norm_g; const float* w_in; const float* na_rpb; const float* q_a_norm; const float* w_q_b;
    const float* kv_a_norm; const float* w_kv_b; const float* gq_norm; const float* gk_norm; const float* w_out; const float* ple_norm; const float* w_pe; const float* w_pg; const float* final_norm;
    float* out; unsigned char* ws; int ph_lo, ph_hi;
};
constexpr int NPHASE = 24;

__device__ __forceinline__ const float* x_row(const Args& a, int grow) { return grow < SEQ_P ? a.xp + (size_t)grow * DM : a.xs + (size_t)(grow - SEQ_P) * DM; }

__device__ __forceinline__ void tr_item(const float* W, int Nsrc, int n_src0, const float* gain, bf16_t* WT, int K, int k0, int n_dst0, bool zero, LAS float* scr, int lane, float mul = 1.0f, bool f16 = false) {
    f32x4 wv[8];
#pragma unroll
    for (int i = 0; i < 8; ++i) { const int kk = 8 * i + (lane >> 3); wv[i] = (f32x4){0.f, 0.f, 0.f, 0.f};
        if (!zero) wv[i] = *(const f32x4*)(W + (size_t)(k0 + kk) * Nsrc + n_src0 + 4 * (lane & 7)); }
#pragma unroll
    for (int i = 0; i < 8; ++i) { const int kk = 8 * i + (lane >> 3); const float gm = (!zero && gain) ? gain[k0 + kk] * mul : mul;
#pragma unroll
        for (int j = 0; j < 4; ++j) scr[kk * 33 + 4 * (lane & 7) + j] = wv[i][j] * gm; }
    LDS_WAIT(); asm volatile("" ::: "memory");
    const int cc = lane & 7;
#pragma unroll
    for (int j = 0; j < 4; ++j) { const int n = (lane >> 3) + 8 * j; const LAS float* s = scr + (8 * cc) * 33 + n;
        u32x4 o;
        if (f16) { o.x = cvt_pk_f16(s[0 * 33], s[1 * 33]); o.y = cvt_pk_f16(s[2 * 33], s[3 * 33]); o.z = cvt_pk_f16(s[4 * 33], s[5 * 33]); o.w = cvt_pk_f16(s[6 * 33], s[7 * 33]); }
        else { o.x = cvt_pk_bf16(s[0 * 33], s[1 * 33]); o.y = cvt_pk_bf16(s[2 * 33], s[3 * 33]); o.z = cvt_pk_bf16(s[4 * 33], s[5 * 33]); o.w = cvt_pk_bf16(s[6 * 33], s[7 * 33]); }
        *(u32x4*)(WT + (size_t)(n_dst0 + n) * K + k0 + 8 * cc) = o; }
    LDS_WAIT(); asm volatile("" ::: "memory");
}
__device__ __forceinline__ int proj_src_col(int n) {
    if (n < C_MLAG) return n;
    if (n < C_GQ) return 2880 + (n - C_MLAG);
    if (n < C_NAK) return 3648 + (n - C_GQ);
    if (n < C_NAV) return 512 + (n - C_NAK);
    if (n < C_NAG) return 1024 + (n - C_NAV);
    if (n < C_CQ) return 1536 + (n - C_NAG);
    if (n < C_CKV) return 2048 + (n - C_CQ);
    if (n < C_GK) return 2560 + (n - C_CKV);
    if (n < C_GV) return 4416 + (n - C_GK);
    if (n < C_GQG) return 4672 + (n - C_GV);
    if (n < C_KR) return 4928 + (n - C_GQG);
    return 2816 + (n - C_KR);
}
__device__ __forceinline__ void sincos_d(double a, float& c, float& s) {
    const double k = __builtin_rint(a * 0.15915494309189535);
    double r = __builtin_fma(-k, 6.283185307179586, a); r = __builtin_fma(-k, 2.4492935982947064e-16, r);
    const double r2 = r * r; double sn = 1.0, cs = 1.0;
#pragma unroll
    for (int i = 12; i >= 1; --i) { sn = 1.0 - r2 * (1.0 / (double)((2 * i) * (2 * i + 1))) * sn; cs = 1.0 - r2 * (1.0 / (double)((2 * i - 1) * (2 * i))) * cs; }
    s = (float)(r * sn); c = (float)cs;
}

__global__ void __launch_bounds__(512, 2) fwd(Args a) {
    extern __shared__ __attribute__((aligned(16))) unsigned char lds_raw[];
    LAS unsigned char* lds = (LAS unsigned char*)lds_raw;
    volatile LAS unsigned* MISC = (volatile LAS unsigned*)(lds + MISC_OFF);
    const int tid = threadIdx.x, lane = tid & 63, wave = __builtin_amdgcn_readfirstlane(tid >> 6);
    const int G = gridDim.x, bx = blockIdx.x;
    const int vcu = (G % 8 == 0) ? (bx % 8) * (G / 8) + bx / 8 : bx;
    unsigned char* ws = a.ws;
    gu32* ctl = (gu32*)(ws + WS_CTL);
    if (tid < 64) MISC[tid] = 0u;
    __syncthreads();
#if MK_PER_PHASE
#define GRID_BAR() do {} while (0)
#else
    XcdBarrier bar = xcd_barrier_post((unsigned*)ctl + CW_BAR, MISC);
#define GRID_BAR() xcd_barrier(bar)
#endif
    const int lo = a.ph_lo, hi = a.ph_hi;
#define IN(k) (lo <= (k) && (k) < hi)
#define SEAM(k) do { if (IN(k) && IN((k) + 1)) { GRID_BAR(); if (PROBE & 64) { GRID_BAR(); GRID_BAR(); GRID_BAR(); GRID_BAR(); } } } while (0)
    const int gw = vcu * 8 + wave, NGW = G * 8;
    bf16_t* W1t = (bf16_t*)(ws + WS_W1); bf16_t* Wqb = (bf16_t*)(ws + WS_WQB); bf16_t* Wkvb = (bf16_t*)(ws + WS_WKVB);
    bf16_t* Wout = (bf16_t*)(ws + WS_WOUT); bf16_t* Wpg = (bf16_t*)(ws + WS_WPG); bf16_t* Wpe = (bf16_t*)(ws + WS_WPE);
    f32x2* ropeT = (f32x2*)(ws + WS_ROPET); f32x2* rowT = (f32x2*)(ws + WS_ROWT); f32x2* colT = (f32x2*)(ws + WS_COLT);
    float* S1 = (float*)(ws + WS_S1); float* S2 = (float*)(ws + WS_S2); float* SQ = (float*)(ws + WS_SQ); float* SKV = (float*)(ws + WS_SKV);
    bf16_t* PB = (bf16_t*)(ws + WS_PB); bf16_t* XB0 = (bf16_t*)(ws + WS_XB0); bf16_t* XB1 = (bf16_t*)(ws + WS_XB1);
    bf16_t* PROJ = (bf16_t*)(ws + WS_PROJ); bf16_t* QB = (bf16_t*)(ws + WS_Q); bf16_t* KVB = (bf16_t*)(ws + WS_KV); bf16_t* PE = (bf16_t*)(ws + WS_PE);

    if (IN(0)) for (int rep_ = 0; rep_ < ((PROBE & 16) ? 2 : 1); ++rep_) {
        const int tid = opaque_tid(), lane = tid & 63;
        LAS float* scr = (LAS float*)(lds + wave * 16384);
        constexpr int I_W1 = 32 * (LDP / 32), I_QB = 8 * (LDQ / 32), I_KVB = 4 * (LDKV / 32), I_SQ = 32 * 64, I_PE = 4 * 64;
        constexpr int I_L = I_W1 + I_QB + I_KVB + 2 * I_SQ + I_PE;
        for (int it = gw; it < 2 * I_L; it += NGW) {
            const int l = it / I_L; int r = it % I_L;
            if (r < I_W1) { const int nb = r % (LDP / 32), kb = r / (LDP / 32), n0 = nb * 32;
                tr_item(a.w_in + (size_t)l * DM * IN_COLS, IN_COLS, n0 < IN_COLS ? proj_src_col(n0) : 0, a.norm_g + l * DM, W1t + (size_t)l * LDP * DM, DM, kb * 64, n0, n0 >= IN_COLS, scr, lane, n0 < C_MLAG ? 0.125f * att::LOG2E : 1.0f, true); continue; }
            r -= I_W1;
            if (r < I_QB) { const int nb = r % (LDQ / 32), kb = r / (LDQ / 32), n0 = nb * 32;
                tr_item(a.w_q_b + (size_t)l * 512 * 1152, 1152, n0 < 1152 ? n0 : 0, a.q_a_norm + l * 512, Wqb + (size_t)l * LDQ * 512, 512, kb * 64, n0, n0 >= 1152, scr, lane); continue; }
            r -= I_QB;
            if (r < I_KVB) { const int nb = r % (LDKV / 32), kb = r / (LDKV / 32), n0 = nb * 32;
                tr_item(a.w_kv_b + (size_t)l * 256 * 1536, 1536, n0, a.kv_a_norm + l * 256, Wkvb + (size_t)l * LDKV * 256, 256, kb * 64, n0, false, scr, lane); continue; }
            r -= I_KVB;
            if (r < I_SQ) { const int nb = r % 64, kb = r / 64;
                tr_item(a.w_out + (size_t)l * DM * DM, DM, nb * 32, nullptr, Wout + (size_t)l * DM * DM, DM, kb * 64, nb * 32, false, scr, lane); continue; }
            r -= I_SQ;
            if (r < I_SQ) { const int nb = r % 64, kb = r / 64;
                tr_item(a.w_pg + (size_t)l * DM * DM, DM, nb * 32, a.ple_norm + l * DM, Wpg + (size_t)l * DM * DM, DM, kb * 64, nb * 32, false, scr, lane, 1.0f, true); continue; }
            r -= I_SQ;
            { const int nb = r % 64, kb = r / 64;
                tr_item(a.w_pe + (size_t)l * PLE * DM, DM, nb * 32, nullptr, Wpe + (size_t)l * DM * PLE, PLE, kb * 64, nb * 32, false, scr, lane); }
        }
        const double RB = 0.7498942093324558273;
        for (int i = (vcu * 512 + tid); i < SEQ_P * 32 + 256 * 16 + 64 * 16; i += G * 512) {
            int pos, j; double base; f32x2* dst;
            if (i < SEQ_P * 32) { pos = i >> 5; j = i & 31; base = RB; dst = ropeT + i; }
            else if (i < SEQ_P * 32 + 256 * 16) { const int k = i - SEQ_P * 32; pos = k >> 4; j = k & 15; base = RB * RB; dst = rowT + k; }
            else { const int k = i - SEQ_P * 32 - 256 * 16; pos = k >> 4; j = k & 15; base = RB * RB; dst = colT + k; }
            double inv = 1.0; for (int q = 0; q < j; ++q) inv *= base;
            float c_, s_; sincos_d((double)pos * inv, c_, s_);
            *dst = (f32x2){c_, s_};
        }
    }

    for (int g = 0; g < 2; ++g) {
        const int row_off = g ? GROWS0 : 0, grows = g ? GROWS1 : GROWS0, nM = grows / 256;
        const int pbase = 1 + g * 11;
        if (IN(pbase)) for (int rep_ = 0; rep_ < ((PROBE & 16) ? 2 : 1); ++rep_) {
            const int tid = opaque_tid(), lane = tid & 63; (void)tid;
            for (int r = gw; r < grows; r += NGW) {
                const f32x4* xr = (const f32x4*)x_row(a, row_off + r) + lane;
                f32x4 v[8]; float s = 0.f;
#pragma unroll
                for (int j = 0; j < 8; ++j) { v[j] = xr[64 * j]; s += (v[j][0] * v[j][0] + v[j][1] * v[j][1]) + (v[j][2] * v[j][2] + v[j][3] * v[j][3]); }
                s = wave_sum(s, lane);
                u32x2* o8 = (u32x2*)(XB0 + (size_t)r * DM) + lane;
#pragma unroll
                for (int j = 0; j < 8; ++j) o8[64 * j] = (u32x2){cvt_pk_f16(v[j][0], v[j][1]), cvt_pk_f16(v[j][2], v[j][3])};
                if (lane < 32) S1[(size_t)r * 32 + lane] = (lane == 0) ? s : 0.f;
            }
            for (int it = gw; it < 2 * grows; it += NGW) {
                const int l = it / grows, r = it % grows, grow = row_off + r;
                const float* pr = grow < SEQ_P ? a.pp + ((size_t)l * SEQ_P + grow) * PLE : a.ps + ((size_t)l * (NTOK - SEQ_P) + (grow - SEQ_P)) * PLE;
                const f32x4 v = ((const f32x4*)pr)[lane];
                ((u32x2*)(PB + ((size_t)l * GMAX + r) * PLE))[lane] = (u32x2){cvt_pk_bf16(v[0], v[1]), cvt_pk_bf16(v[2], v[3])};
            }
        }
        SEAM(pbase);
        for (int l = 0; l < 2; ++l) {
            const int ph = pbase + 1 + l * 5;
            bf16_t* XBa = (l == 0) ? XB0 : XB1; bf16_t* XBb = (l == 0) ? XB1 : XB0;
            if (IN(ph)) {
                pg8::Gemm gm{XBa, W1t + (size_t)l * LDP * DM};
                pg8::StaticOrder S; S.init(nM, LDP / 256, G, bx, WGM_P1);
                pg8::EpiBf16<true, true> E{PROJ, LDP, pg8::RowScale{S1, 32, 1.0f / DM}, SQ, SKV, TILE_CQ0, 1.0f};
                pg8::gemm_phase<DM, DM, decltype(E), true>(lds, gm, S, E);
                if (PROBE & 1) pg8::gemm_phase<DM, DM, decltype(E), true>(lds, gm, S, E);
            }
            SEAM(ph);
            if (IN(ph + 1)) {
                const int tid = opaque_tid(), lane = tid & 63; (void)tid;
                const float* gk = a.gk_norm + l * 64;
                for (int it = gw; it < grows / 2; it += NGW) {
                    const int r = it * 2 + (lane >> 5), hd = (lane >> 3) & 3, sub = lane & 7;
                    const int grow = row_off + r; const int t = grow < SEQ_P ? grow : (grow - SEQ_P) & (SEQ_S - 1);
                    bf16_t* p = PROJ + (size_t)r * LDP + C_GK + hd * 64 + sub * 8;
                    const bf16x8 v = *(const bf16x8*)p; float x[8], y[8]; float ss = 0.f;
#pragma unroll
                    for (int i = 0; i < 8; ++i) { x[i] = bf2f(v[i]); ss += x[i] * x[i]; }
                    ss += shx(ss, 1, lane); ss += shx(ss, 2, lane); ss += shx(ss, 4, lane);
                    const float rstd = 1.0f / sqrtf(ss * (1.0f / 64.0f) + EPS);
#pragma unroll
                    for (int i = 0; i < 8; ++i) x[i] *= rstd * gk[sub * 8 + i];
                    const f32x2* tb = (sub < 4 ? rowT + (t >> 6) * 16 : colT + (t & 63) * 16) + (sub & 1) * 8;
                    const bool second = (sub & 2) != 0;
#pragma unroll
                    for (int i = 0; i < 8; ++i) { const float o_ = shx(x[i], 2, lane); const f32x2 cs = tb[i]; y[i] = second ? x[i] * cs.x + o_ * cs.y : x[i] * cs.x - o_ * cs.y; }
                    *(u32x4*)p = (u32x4){cvt_pk_bf16(y[0], y[1]), cvt_pk_bf16(y[2], y[3]), cvt_pk_bf16(y[4], y[5]), cvt_pk_bf16(y[6], y[7])};
                    { int w0 = 0, w1 = 0;
                      w0 = __builtin_amdgcn_cvt_pk_fp8_f32(y[0], y[1], w0, false); w0 = __builtin_amdgcn_cvt_pk_fp8_f32(y[2], y[3], w0, true);
                      w1 = __builtin_amdgcn_cvt_pk_fp8_f32(y[4], y[5], w1, false); w1 = __builtin_amdgcn_cvt_pk_fp8_f32(y[6], y[7], w1, true);
                      *(u32x2*)(ws + WS_KF8 + (((size_t)(r >> 6) * 4 + hd) * 4 + (sub >> 1)) * 1024 + (r & 63) * 16 + 8 * (sub & 1)) = (u32x2){(unsigned)w0, (unsigned)w1}; }
                }
                for (int it = gw; it < (grows >> 6) * 4; it += NGW) {
                    const int T = it >> 2, hd = it & 3; const int slot = att::g8_slot(lane);
                    const bf16_t* vr = PROJ + ((size_t)T * 64 + lane) * LDP + C_GV + hd * 64;
                    LAS unsigned char* vo = lds + wave * 4096 + (slot & 15);
                    bf16x8 vv[8];
#pragma unroll
                    for (int cg = 0; cg < 8; ++cg) vv[cg] = *(const bf16x8*)(vr + cg * 8);
#pragma unroll
                    for (int cg = 0; cg < 8; ++cg) {
                        int w0 = 0, w1 = 0;
                        w0 = __builtin_amdgcn_cvt_pk_fp8_f32(bf2f(vv[cg][0]), bf2f(vv[cg][1]), w0, false); w0 = __builtin_amdgcn_cvt_pk_fp8_f32(bf2f(vv[cg][2]), bf2f(vv[cg][3]), w0, true);
                        w1 = __builtin_amdgcn_cvt_pk_fp8_f32(bf2f(vv[cg][4]), bf2f(vv[cg][5]), w1, false); w1 = __builtin_amdgcn_cvt_pk_fp8_f32(bf2f(vv[cg][6]), bf2f(vv[cg][7]), w1, true);
#pragma unroll
                        for (int e = 0; e < 8; ++e) { const int col = cg * 8 + e; const unsigned wv = e < 4 ? (unsigned)w0 : (unsigned)w1;
                            vo[col * 64 + ((((slot >> 4) ^ ((col >> 2) & 3))) << 4)] = (unsigned char)(wv >> (8 * (e & 3))); }
                    }
                    asm volatile("s_waitcnt lgkmcnt(0)" ::: "memory");
                    { const LAS unsigned char* li = lds + wave * 4096 + lane * 16; unsigned char* go = ws + WS_GV8 + (size_t)it * 4096 + lane * 16;
#pragma unroll
                      for (int p = 0; p < 4; ++p) *(u32x4*)(go + p * 1024) = *(const LAS u32x4*)(li + p * 1024); }
                    asm volatile("s_waitcnt lgkmcnt(0)" ::: "memory");
                }
                for (int it = gw; it < grows / 8; it += NGW) {
                    const int r = it * 8 + (lane >> 3), sub = lane & 7;
                    const int grow = row_off + r; const int t = grow < SEQ_P ? grow : (grow - SEQ_P) & (SEQ_S - 1);
                    bf16_t* p = PROJ + (size_t)r * LDP + C_KR + sub * 8;
                    const bf16x8 v = *(const bf16x8*)p; float x[8], y[8];
#pragma unroll
                    for (int i = 0; i < 8; ++i) x[i] = bf2f(v[i]);
                    const f32x2* tb = ropeT + (size_t)t * 32 + (sub & 3) * 8; const bool second = (sub & 4) != 0;
#pragma unroll
                    for (int i = 0; i < 8; ++i) { const float o_ = shx(x[i], 4, lane); const f32x2 cs = tb[i]; y[i] = second ? x[i] * cs.x + o_ * cs.y : x[i] * cs.x - o_ * cs.y; }
                    *(u32x4*)p = (u32x4){cvt_pk_bf16(y[0], y[1]), cvt_pk_bf16(y[2], y[3]), cvt_pk_bf16(y[4], y[5]), cvt_pk_bf16(y[6], y[7])};
                    { int w0 = 0, w1 = 0;
                      w0 = __builtin_amdgcn_cvt_pk_fp8_f32(y[0], y[1], w0, false); w0 = __builtin_amdgcn_cvt_pk_fp8_f32(y[2], y[3], w0, true);
                      w1 = __builtin_amdgcn_cvt_pk_fp8_f32(y[4], y[5], w1, false); w1 = __builtin_amdgcn_cvt_pk_fp8_f32(y[6], y[7], w1, true);
                      const int d0_ = sub * 8; const int pos = 32 * ((d0_ & 31) >> 4) + 16 * (d0_ >> 5) + (d0_ & 15);
                      *(u32x2*)(ws + WS_KR8 + ((size_t)(r >> 6) * 4 + (pos >> 4)) * 1024 + (r & 63) * 16 + (pos & 15)) = (u32x2){(unsigned)w0, (unsigned)w1}; }
                }
                VM_WAIT(); __syncthreads();
                { pg8::Gemm gm{PROJ + C_CQ, Wqb + (size_t)l * LDQ * 512};
                  pg8::StaticOrder S; S.init(nM, LDQ / 256, G, bx, WGM_SM);
                  pg8::EpiBf16<true, false> E{QB, LDQ, pg8::RowScale{SQ, 8, 1.0f / 512}, nullptr, nullptr, 0, att::Cfg<0>::SCALE * att::LOG2E};
                  pg8::gemm_phase<LDP, 512>(lds, gm, S, E); if (PROBE & 1) pg8::gemm_phase<LDP, 512>(lds, gm, S, E); }
                { pg8::Gemm gm{PROJ + C_CKV, Wkvb + (size_t)l * LDKV * 256};
                  pg8::StaticOrder S; S.init(nM, LDKV / 256, G, bx, WGM_SM);
                  pg8::EpiKV8 E{ws + WS_KN8, ws + WS_V8, pg8::RowScale{SKV, 4, 1.0f / 256}};
                  pg8::gemm_phase<LDP, 256, decltype(E), false, true>(lds, gm, S, E); if (PROBE & 1) pg8::gemm_phase<LDP, 256, decltype(E), false, true>(lds, gm, S, E); }
            }
            SEAM(ph + 1);
            if (IN(ph + 2)) {
                const int tid = opaque_tid();
                att::Ctx cx{PROJ, QB, KVB, (const unsigned char*)(ws + WS_KF8), (const unsigned char*)(ws + WS_GV8), (const unsigned char*)(ws + WS_KN8), (const unsigned char*)(ws + WS_V8), (const unsigned char*)(ws + WS_KR8), ropeT, rowT, colT, a.gq_norm + l * 64, a.gk_norm + l * 64, a.na_rpb + (size_t)l * 8 * 15 * 31};
                bool gq_ok;
                { const int ln = tid & 63; float gqm = fabsf(cx.gq_norm[ln]), gkm = fabsf(cx.gk_norm[ln]);
#pragma unroll
                  for (int o_ = 1; o_ < 16; o_ <<= 1) { gqm = fmaxf(gqm, shx(gqm, o_, ln)); gkm = fmaxf(gkm, shx(gkm, o_, ln)); }
                  gqm = fmaxf(gqm, part16(gqm)); gkm = fmaxf(gkm, part16(gkm)); gqm = fmaxf(gqm, part32(gqm)); gkm = fmaxf(gkm, part32(gkm));
                  const float Mb = 64.0f * gqm * gkm * 0.125f * att::LOG2E;
                  gq_ok = __builtin_amdgcn_readfirstlane((int)(Mb <= 15.0f)) != 0; }
                gu32* qh = ctl + CW_QUEUE + 64 * ((g * 2 + l) * 3);
#define ATT_LOOP(KIND, REPS) do { constexpr int H_ = (KIND == 1) ? 4 : att::Cfg<KIND>::H; const int total = (g == 0 ? 128 : 64) * H_; \
                for (int rep = 0; rep < (REPS); ++rep) { const bool dry = rep + 1 < (REPS); \
                for (;;) { if (tid == 0) MISC[4] = __hip_atomic_fetch_add(qh + 64 * (KIND + 12 * rep), 1u, __ATOMIC_RELAXED, __HIP_MEMORY_SCOPE_AGENT); \
                    __syncthreads(); const int idx = __builtin_amdgcn_readfirstlane((int)MISC[4]); __syncthreads(); \
                    if (idx >= total) break; \
                    int s0, slen, hh, qb; \
                    if (g == 0 && idx < 64 * H_) { s0 = 0; slen = SEQ_P; hh = idx >> 6; qb = idx & 63; } \
                    else { const int k = (g == 0) ? idx - 64 * H_ : idx; const int sq = k / (8 * H_), rem = k % (8 * H_); s0 = (g == 0 ? SEQ_P : 0) + sq * SEQ_S; slen = SEQ_S; hh = rem >> 3; qb = rem & 7; } \
                    if (KIND == 1) { if (gq_ok) att::gqa9_unit(cx, s0, slen, hh, qb, lds, dry); else { for (int h3 = 0; h3 < 3; ++h3) att::attn_unit<1>(cx, s0, slen, hh * 3 + h3, qb, lds, dry); } } \
                    else if (KIND == 2) att::na_unit(cx, s0, slen, hh, qb, lds, dry); else att::mla9_unit(cx, s0, slen, hh, qb, lds, dry); } } } while (0)
                ATT_LOOP(0, (PROBE & 2) ? 2 : 1);
                ATT_LOOP(1, (PROBE & 4) ? 2 : 1);
                ATT_LOOP(2, (PROBE & 8) ? 2 : 1);
#undef ATT_LOOP
            }
            SEAM(ph + 2);
            if (IN(ph + 3)) {
                { pg8::Gemm gm{PROJ, Wout + (size_t)l * DM * DM};
                  pg8::StaticOrder S; S.init(nM, DM / 256, G, bx, WGM_SQ);
                  pg8::EpiRes1 E{XBa, S2};
                  pg8::gemm_phase<LDP, DM>(lds, gm, S, E); }
                { pg8::Gemm gm{PB + (size_t)l * GMAX * PLE, Wpe + (size_t)l * DM * PLE};
                  pg8::StaticOrder S; S.init(nM, DM / 256, G, bx, WGM_SQ);
                  pg8::EpiBf16<false, false> E{PE, DM, pg8::RowScale{nullptr, 0, 0.f}, nullptr, nullptr, 0, 1.0f};
                  pg8::gemm_phase<PLE, PLE>(lds, gm, S, E); if (PROBE & 1) pg8::gemm_phase<PLE, PLE>(lds, gm, S, E); }
            }
            SEAM(ph + 3);
            if (IN(ph + 4)) {
                pg8::Gemm gm{XBa, Wpg + (size_t)l * DM * DM};
                pg8::StaticOrder S; S.init(nM, DM / 256, G, bx, WGM_SQ);
                pg8::EpiGate E{XBa, PE, XBb, S1, pg8::RowScale{S2, 32, 1.0f / DM}};
                pg8::gemm_phase<DM, DM, decltype(E), true>(lds, gm, S, E);
            }
            SEAM(ph + 4);
        }
        const int pf = (g == 0) ? 12 : 23;
        if (IN(pf)) {
            const int tid = opaque_tid(), lane = tid & 63; (void)tid;
            for (int r = gw; r < grows; r += NGW) {
                const f32x4 sv = ((const f32x4*)(S1 + (size_t)r * 32))[lane & 7];
                float s = (sv[0] + sv[1]) + (sv[2] + sv[3]); s += shx(s, 1, lane); s += shx(s, 2, lane); s += shx(s, 4, lane);
                const float rstd = 1.0f / sqrtf(s * (1.0f / DM) + EPS);
                f32x4* orow = (f32x4*)(a.out + (size_t)(row_off + r) * DM) + lane; const f32x4* fg = (const f32x4*)a.final_norm + lane;
                const u32x2* xr = (const u32x2*)(XB0 + (size_t)r * DM) + lane;
                u32x2 xv[8];
#pragma unroll
                for (int j = 0; j < 8; ++j) xv[j] = xr[64 * j];
#pragma unroll
                for (int j = 0; j < 8; ++j) { const f32x4 v = {h_lo(xv[j].x), h_hi(xv[j].x), h_lo(xv[j].y), h_hi(xv[j].y)}, gg = fg[64 * j]; orow[64 * j] = v * rstd * gg; }
            }
            if (g == 0) { VM_WAIT(); __syncthreads(); }
        }
    }
#undef IN
#undef SEAM
#undef GRID_BAR
}

extern "C" void kernel_launch(void* const* d_in, const int* in_sizes, int n_in, void* d_out, int out_size, void* d_ws, size_t ws_size, hipStream_t stream) {
    static int grid = 0;
    if (grid == 0) {
        if (n_in != 18 || out_size != NTOK * DM || ws_size < WS_END) { fprintf(stderr, "kernel_launch: shape mismatch (n_in %d, out %d, ws %zu < %zu)\n", n_in, out_size, ws_size, (size_t)WS_END); grid = -1; return; }
        int dev = 0, cus = 0;
        if (hipGetDevice(&dev) != hipSuccess || hipDeviceGetAttribute(&cus, hipDeviceAttributeMultiprocessorCount, dev) != hipSuccess) { grid = -1; return; }
        if (hipFuncSetAttribute((const void*)fwd, hipFuncAttributeMaxDynamicSharedMemorySize, LDS_BYTES) != hipSuccess) { fprintf(stderr, "kernel_launch: hipFuncSetAttribute failed\n"); grid = -1; return; }
        int per_cu = 0;
        if (hipOccupancyMaxActiveBlocksPerMultiprocessor(&per_cu, (const void*)fwd, 512, LDS_BYTES) != hipSuccess || per_cu < 1) fprintf(stderr, "kernel_launch: occupancy query reports %d\n", per_cu);
        (void)hipGetLastError();
        grid = cus;
    }
    if (grid < 0) return;
    if (hipMemsetAsync((char*)d_ws + WS_CTL, 0, CTL_ZERO_BYTES, stream) != hipSuccess) return;
    Args a{};
    a.xp = (const float*)d_in[0]; a.xs = (const float*)d_in[1]; a.pp = (const float*)d_in[2]; a.ps = (const float*)d_in[3]; a.norm_g = (const float*)d_in[4]; a.w_in = (const float*)d_in[5];
    a.na_rpb = (const float*)d_in[6]; a.q_a_norm = (const float*)d_in[7]; a.w_q_b = (const float*)d_in[8]; a.kv_a_norm = (const float*)d_in[9]; a.w_kv_b = (const float*)d_in[10];
    a.gq_norm = (const float*)d_in[11]; a.gk_norm = (const float*)d_in[12]; a.w_out = (const float*)d_in[13]; a.ple_norm = (const float*)d_in[14]; a.w_pe = (const float*)d_in[15];
    a.w_pg = (const float*)d_in[16]; a.final_norm = (const float*)d_in[17];
    a.out = (float*)d_out; a.ws = (unsigned char*)d_ws;
#if MK_PER_PHASE
    for (int p = 0; p < NPHASE; ++p) { a.ph_lo = p; a.ph_hi = p + 1; hipLaunchKernelGGL(fwd, dim3(grid), dim3(512), LDS_BYTES, stream, a); }
#else
    a.ph_lo = 0; a.ph_hi = NPHASE; hipLaunchKernelGGL(fwd, dim3(grid), dim3(512), LDS_BYTES, stream, a);
#endif
    const hipError_t le = hipPeekAtLastError();
    if (le != hipSuccess) fprintf(stderr, "kernel_launch: launch failed: %s\n", hipGetErrorName(le));
}
```
